# Optimizing an MI355X kernel written in HIP

```python
import jax
import jax.numpy as jnp
from jax import lax
import numpy as np

D_MODEL = 1024
BATCH = 4
SEQ = 8192
DEPTH = 1
DEC_BATCH = 1
DEC_SEQ = 16384
PAST_LEN = 128

D_A = D_MODEL
D_B = D_MODEL
D_MIX = D_A + D_B
H_A = 8
HD_A = D_A // H_A
H_B = 8
HD_B = D_B // H_B
GMLP_CHUNK = 128
HGRN_CHUNK = 64
D_IN = 3 * D_A + 5 * D_B
EPS = 1e-6

kernel_name = 'bidir_gmlp_hgrn2_hybrid'


def rmsnorm(x, g):
    xf = x.astype(jnp.float32)
    y = xf * lax.rsqrt(jnp.mean(xf * xf, axis=-1, keepdims=True) + EPS)
    return (y * g.astype(jnp.float32)).astype(x.dtype)


def layernorm(x, g, b):
    xf = x.astype(jnp.float32)
    xc = xf - jnp.mean(xf, axis=-1, keepdims=True)
    y = xc * lax.rsqrt(jnp.mean(xc * xc, axis=-1, keepdims=True) + EPS)
    return (y * g.astype(jnp.float32) + b.astype(jnp.float32)).astype(x.dtype)


def gmlp_spatial_gating(u, v, ln_g, ln_b, w_s, b_s):
    bsz, seq, _ = u.shape
    vn = layernorm(v, ln_g, ln_b).reshape(bsz, seq // GMLP_CHUNK, GMLP_CHUNK, H_A, HD_A)
    s = jnp.einsum('hts,bnshc->bnthc', w_s, vn) + b_s.T[:, :, None]
    return u * s.reshape(bsz, seq, D_A)


def gla_chunk_scan(q, k, g, v):
    bsz, seq, nh, dk = q.shape
    dv = v.shape[-1]
    n_chunks = seq // HGRN_CHUNK

    def to_chunks(t):
        return t.reshape(bsz, n_chunks, HGRN_CHUNK, nh, t.shape[-1]).transpose(1, 0, 3, 2, 4)

    incl = jnp.tril(jnp.ones((HGRN_CHUNK, HGRN_CHUNK), dtype=bool))[:, :, None]

    def step(state, chunk):
        qc, kc, gc, vc = chunk
        b = jnp.cumsum(gc, axis=2)
        o_inter = jnp.einsum('bhtk,bhkv->bhtv', qc * jnp.exp(b), state)
        diff = b[:, :, :, None, :] - b[:, :, None, :, :]
        decay = jnp.exp(jnp.where(incl, diff, -jnp.inf))
        scores = jnp.einsum('bhtsk,bhsk->bhts', qc[:, :, :, None, :] * decay, kc)
        o = o_inter + jnp.einsum('bhts,bhsv->bhtv', scores, vc)
        b_end = b[:, :, -1:, :]
        new_state = (jnp.exp(b_end[:, :, 0, :])[..., None] * state
                     + jnp.einsum('bhsk,bhsv->bhkv', kc * jnp.exp(b_end - b), vc))
        return new_state, o

    s0 = jnp.zeros((bsz, nh, dk, dv), jnp.float32)
    _, o = lax.scan(step, s0, (to_chunks(q), to_chunks(k), to_chunks(g), to_chunks(v)))
    return o.transpose(1, 0, 3, 2, 4).reshape(bsz, seq, nh, dv)


def hgrn2_bidirectional(q, f_fwd, f_bwd, i, lb_fwd, lb_bwd, gn_g, z):
    bsz, seq, _ = q.shape

    def heads(t):
        return t.astype(jnp.float32).reshape(bsz, seq, H_B, HD_B)

    qh = heads(jax.nn.silu(q))
    ih = heads(i)

    def one_direction(f_logit, lb, reverse):
        fg = lb + (1.0 - lb) * jax.nn.sigmoid(f_logit.astype(jnp.float32))
        args = (qh, heads(1.0 - fg), heads(jnp.log(fg)), ih)
        if reverse:
            args = tuple(jnp.flip(t, axis=1) for t in args)
        o = gla_chunk_scan(*args)
        return jnp.flip(o, axis=1) if reverse else o

    o = one_direction(f_fwd, lb_fwd, False) + one_direction(f_bwd, lb_bwd, True)
    o = o * lax.rsqrt(jnp.mean(o * o, axis=-1, keepdims=True) + EPS)
    o = o.reshape(bsz, seq, D_B) * gn_g.astype(jnp.float32)
    return (o * jax.nn.silu(z.astype(jnp.float32))).astype(z.dtype)


def encoder_trunk(x, norm_g, w_in, ln_v_g, ln_v_b, w_s, b_s, lb_params, gn_g, w_out, final_g):
    lower_bounds = jnp.cumsum(jax.nn.softmax(lb_params.astype(jnp.float32), axis=1), axis=1)
    cuts = [D_A, 2 * D_A, 3 * D_A, 3 * D_A + D_B, 3 * D_A + 2 * D_B,
            3 * D_A + 3 * D_B, 3 * D_A + 4 * D_B]
    for layer in range(DEPTH):
        h = rmsnorm(x, norm_g[layer])
        proj = jnp.einsum('bld,de->ble', h, w_in[layer])
        u_a, v_a, z_a, q_b, f_fwd, f_bwd, i_b, z_b = jnp.split(proj, cuts, axis=-1)
        out_a = gmlp_spatial_gating(u_a, v_a, ln_v_g[layer], ln_v_b[layer],
                                    w_s[layer], b_s[layer]) * jax.nn.silu(z_a)
        out_b = hgrn2_bidirectional(q_b, f_fwd, f_bwd, i_b, lower_bounds[0, layer],
                                    lower_bounds[1, layer], gn_g[layer], z_b)
        mixed = jnp.concatenate([out_a, out_b], axis=-1)
        x = x + jnp.einsum('ble,ed->bld', mixed, w_out[layer]).astype(x.dtype)
    return rmsnorm(x, final_g)


def setup_inputs(seed: int = 0) -> dict:
    key = jax.random.key(seed)
    ks = jax.random.split(key, 12)
    f32 = jnp.float32

    def nrm(k, shape, scale):
        return scale * jax.random.normal(k, shape, f32)

    return {
        'x_prompt': jax.random.normal(ks[0], (BATCH, SEQ, D_MODEL), f32),
        'x_sample': jax.random.normal(ks[1], (DEC_BATCH, DEC_SEQ, D_MODEL), f32),
        'norm_g': 1.0 + nrm(ks[2], (DEPTH, D_MODEL), 0.02),
        'w_in': nrm(ks[3], (DEPTH, D_MODEL, D_IN), D_MODEL ** -0.5),
        'ln_v_g': 1.0 + nrm(ks[4], (DEPTH, D_A), 0.02),
        'ln_v_b': nrm(ks[5], (DEPTH, D_A), 0.02),
        'w_s': nrm(ks[6], (DEPTH, H_A, GMLP_CHUNK, GMLP_CHUNK), GMLP_CHUNK ** -0.5),
        'b_s': 1.0 + nrm(ks[7], (DEPTH, H_A, GMLP_CHUNK), 0.02),
        'lb_params': nrm(ks[8], (2, DEPTH + 1, D_B), 0.1),
        'gn_g': 1.0 + nrm(ks[9], (DEPTH, D_B), 0.02),
        'w_out': nrm(ks[10], (DEPTH, D_MIX, D_MODEL), D_MIX ** -0.5),
        'final_g': 1.0 + nrm(ks[11], (D_MODEL,), 0.02),
    }


def reference(x_prompt, x_sample, norm_g, w_in, ln_v_g, ln_v_b, w_s, b_s, lb_params, gn_g, w_out, final_g):
    y_prompt = encoder_trunk(x_prompt, norm_g, w_in, ln_v_g, ln_v_b, w_s, b_s,
                             lb_params, gn_g, w_out, final_g)
    y_sample = encoder_trunk(x_sample, norm_g, w_in, ln_v_g, ln_v_b, w_s, b_s,
                             lb_params, gn_g, w_out, final_g)
    return (y_prompt, y_sample)
```

```cpp
#include <hip/hip_runtime.h>
#include <hip/hip_cooperative_groups.h>
#include <cstdio>
#include <cstdint>
namespace pg8 {
#define PG8_LAS __attribute__((address_space(3)))
typedef unsigned short bf16_t;
typedef short bf16x8 __attribute__((ext_vector_type(8)));
typedef float f32x4 __attribute__((ext_vector_type(4)));
typedef unsigned u32x4 __attribute__((ext_vector_type(4)));
constexpr int BM = 256, BK = 64, HALF = 128, HTB = HALF * BK * 2  , STAGE_BYTES = 8 * HTB, NXCD = 8, WGM = 8;

__host__ __device__ __forceinline__ int lds_byte(int r, int c) { const int st = (r >> 4) * 2 + (c >> 5), rr = r & 15, cc = c & 31, ob = rr * 64 + cc * 2; return st * 1024 + (ob ^ (((ob >> 9) & 1) << 5)); }
__host__ __device__ __forceinline__ void stage_rc(int b, int& R, int& C) { const int st = b / 1024, sb = b % 1024, swz = sb ^ (((sb >> 9) & 1) << 5); R = (st >> 1) * 16 + swz / 64; C = (st & 1) * 32 + (swz % 64) / 2; }
__host__ __device__ __forceinline__ int perm32(int rho) { const int n = rho >> 4, i = rho & 15; return 8 * (i >> 2) + 4 * n + (i & 3); }

struct Unit { int pm, pn; };
struct Gemm { const bf16_t* A; const bf16_t* Bt; int M, N, K, lda; };

struct StaticOrder {
    int nM, nN, nwg, G, c;
    __host__ __device__ void init(int M, int N, int G_, int c_) { nM = M / BM; nN = N / BM; nwg = nM * nN; G = G_; c = c_; }
    __host__ __device__ bool next(int i, Unit& u) const {
        const long L = (long)i * G + c; if (L >= nwg) return false;
        int wgid = (int)L; { const int q = nwg / NXCD, r = nwg % NXCD, xcd = wgid % NXCD, off = wgid / NXCD; wgid = (xcd < r ? xcd * (q + 1) : r * (q + 1) + (xcd - r) * q) + off; }
        const int nig = WGM * nN, gid = wgid / nig, fm = gid * WGM, gsz = (nM - fm) < WGM ? (nM - fm) : WGM;
        u.pm = fm + ((wgid % nig) % gsz); u.pn = (wgid % nig) / gsz; return true;
    }
    __device__ __forceinline__ void a_ready(const Unit&) const {}
    __device__ __forceinline__ void done(const Unit&) const {}
};
__device__ __forceinline__ unsigned cvt_pk_bf16(float lo, float hi) { unsigned r; asm volatile("v_cvt_pk_bf16_f32 %0, %1, %2" : "=v"(r) : "v"(lo), "v"(hi)); return r; }
typedef float f32x2 __attribute__((ext_vector_type(2)));

template <class Epi, class Sched, bool ALIGN_EPI = false, bool SP2 = false>
__device__ __forceinline__ void gemm_phase(PG8_LAS unsigned char* lds, const Gemm g, const Sched& S, const Epi& E) {
    int tid_ = threadIdx.x; asm volatile("" : "+v"(tid_));
    const int tid = tid_, wid = __builtin_amdgcn_readfirstlane(tid >> 6), lane = tid & 63, wr = wid >> 2, wc = wid & 3, fr = lane & 15, fq = lane >> 4;
    const int K = g.K, nt = K / BK;
    unsigned voffA[2], voffB[2];
#pragma unroll
    for (int i = 0; i < 2; ++i) { int R, C; stage_rc(tid * 16 + i * 8192, R, C); const int Rb = Epi::PERM ? ((R & ~31) + perm32(R & 31)) : R;
        voffA[i] = (unsigned)(R * g.lda + C) * 2u; voffB[i] = (unsigned)(Rb * K + C) * 2u; }
    const size_t kstep = (size_t)(BK * 2);
    const size_t hstep = (size_t)HALF * K * 2, hstepA = (size_t)HALF * g.lda * 2;
    const size_t tstep = 2 * hstep, tstepA = 2 * hstepA;
    const unsigned ldsw = (unsigned)wid * 1024u;
    const int aoff = lds_byte(wr * 64 + fr, fq * 8), boff = lds_byte(wc * 32 + fr, fq * 8);
#define PG8_SA(b, h) (((b) * 2 + (h)) * HTB)
#define PG8_SB(b, h) ((4 + (b) * 2 + (h)) * HTB)
#define PG8_STAGE(bufoff, gbase, voff) do { _Pragma("unroll") for (int _i = 0; _i < 2; ++_i) \
        __builtin_amdgcn_global_load_lds((const unsigned*)((const char*)(gbase) + (voff)[_i]), (PG8_LAS unsigned*)(lds + (bufoff) + ldsw + _i * 8192), 16, 0, 0); } while (0)
#define PG8_LDA(dst, b, h) do { _Pragma("unroll") for (int m = 0; m < 4; ++m) _Pragma("unroll") for (int k = 0; k < 2; ++k) dst[m][k] = *(const PG8_LAS bf16x8*)(lds + PG8_SA(b, h) + aoff + m * 2048 + k * 1024); } while (0)
#define PG8_LDB(dst, b, h) do { _Pragma("unroll") for (int n = 0; n < 2; ++n) _Pragma("unroll") for (int k = 0; k < 2; ++k) dst[n][k] = *(const PG8_LAS bf16x8*)(lds + PG8_SB(b, h) + boff + n * 2048 + k * 1024); } while (0)
#define PG8_MMA(ai, bj, At, Bt) do { __builtin_amdgcn_s_setprio(1); _Pragma("unroll") for (int m = 0; m < 4; ++m) _Pragma("unroll") for (int n = 0; n < 2; ++n) _Pragma("unroll") for (int k = 0; k < 2; ++k) \
        acc[ai][bj][m][n] = __builtin_amdgcn_mfma_f32_16x16x32_bf16(Bt[n][k], At[m][k], acc[ai][bj][m][n], 0, 0, 0); __builtin_amdgcn_s_setprio(0); } while (0)
#define PG8_WAIT_V(n) asm volatile("s_waitcnt vmcnt(" #n ")" ::: "memory")
#define PG8_WAIT_L(n) asm volatile("s_waitcnt lgkmcnt(" #n ")" ::: "memory")
#define PG8_BAR __builtin_amdgcn_s_barrier()
#define PG8_SCHED __builtin_amdgcn_sched_barrier(0)
    Unit cur, nxt; int ui = 0;
    if (!S.next(0, cur)) return;
    f32x4 acc[2][2][4][2];
#pragma unroll
    for (int a = 0; a < 2; ++a)
#pragma unroll
        for (int b = 0; b < 2; ++b)
#pragma unroll
            for (int m = 0; m < 4; ++m)
#pragma unroll
                for (int n = 0; n < 2; ++n) acc[a][b][m][n] = (f32x4){0.f, 0.f, 0.f, 0.f};
    bf16x8 At[4][2], B0[2][2], B1[2][2];
    const char* cA = (const char*)g.A + (size_t)cur.pm * tstepA; const char* cB = (const char*)g.Bt + (size_t)cur.pn * tstep;
    S.a_ready(cur);
    if constexpr (SP2) {
        PG8_STAGE(PG8_SB(0, 0), cB, voffB); PG8_STAGE(PG8_SB(0, 1), cB + hstep, voffB); PG8_STAGE(PG8_SA(0, 0), cA, voffA); PG8_STAGE(PG8_SA(0, 1), cA + hstepA, voffA);
        if (wr == 1) PG8_BAR;
        PG8_WAIT_V(2); PG8_BAR;
        PG8_STAGE(PG8_SB(1, 0), cB + kstep, voffB); PG8_STAGE(PG8_SA(1, 0), cA + kstep, voffA); PG8_STAGE(PG8_SB(1, 1), cB + hstep + kstep, voffB);
        PG8_WAIT_V(6); PG8_BAR;
    } else {
        PG8_STAGE(PG8_SB(0, 0), cB, voffB); PG8_STAGE(PG8_SA(0, 0), cA, voffA); PG8_STAGE(PG8_SB(0, 1), cB + hstep, voffB); PG8_STAGE(PG8_SA(0, 1), cA + hstepA, voffA);
        if (wr == 1) PG8_BAR;
        PG8_WAIT_V(4); PG8_BAR;
        PG8_STAGE(PG8_SB(1, 0), cB + kstep, voffB); PG8_STAGE(PG8_SA(1, 0), cA + kstep, voffA); PG8_STAGE(PG8_SB(1, 1), cB + hstep + kstep, voffB);
        PG8_WAIT_V(6); PG8_BAR;
    }
    for (;;) {
        const bool has_next = S.next(ui + 1, nxt);
        const char* nA = has_next ? (const char*)g.A + (size_t)nxt.pm * tstepA : cA; const char* nB = has_next ? (const char*)g.Bt + (size_t)nxt.pn * tstep : cB;
        for (int t = 0; t < nt; t += 2) {
            const bool last = (t == nt - 2);
            const char* a1 = cA + (size_t)(t + 1) * kstep;
            const char* a2 = last ? nA : cA + (size_t)(t + 2) * kstep; const char* b2 = last ? nB : cB + (size_t)(t + 2) * kstep;
            const char* a3 = a2 + kstep; const char* b3 = b2 + kstep;
            if (last && has_next) S.a_ready(nxt);
            if constexpr (SP2) {
            PG8_LDB(B0, 0, 0); PG8_LDB(B1, 0, 1); PG8_SCHED; PG8_LDA(At, 0, 0); PG8_STAGE(PG8_SA(1, 1), a1 + hstepA, voffA);
            PG8_WAIT_V(8); PG8_WAIT_L(0); PG8_BAR; PG8_MMA(0, 0, At, B0); PG8_MMA(0, 1, At, B1); PG8_BAR; PG8_SCHED;
            PG8_LDA(At, 0, 1); PG8_STAGE(PG8_SB(0, 0), b2, voffB); PG8_STAGE(PG8_SB(0, 1), b2 + hstep, voffB); PG8_STAGE(PG8_SA(0, 0), a2, voffA);
            PG8_WAIT_V(8); PG8_WAIT_L(0); PG8_BAR; PG8_MMA(1, 0, At, B0); PG8_MMA(1, 1, At, B1); PG8_BAR; PG8_SCHED;
            PG8_LDB(B0, 1, 0); PG8_LDB(B1, 1, 1); PG8_SCHED; PG8_LDA(At, 1, 0); PG8_STAGE(PG8_SA(0, 1), a2 + hstepA, voffA);
            PG8_WAIT_V(8); PG8_WAIT_L(0); PG8_BAR; PG8_MMA(0, 0, At, B0); PG8_MMA(0, 1, At, B1); PG8_BAR; PG8_SCHED;
            PG8_LDA(At, 1, 1); PG8_STAGE(PG8_SB(1, 0), b3, voffB); PG8_STAGE(PG8_SB(1, 1), b3 + hstep, voffB); PG8_STAGE(PG8_SA(1, 0), a3, voffA);
            PG8_WAIT_V(8); PG8_WAIT_L(0); PG8_BAR; PG8_MMA(1, 0, At, B0); PG8_MMA(1, 1, At, B1); PG8_BAR; PG8_SCHED;
            } else {
            PG8_LDB(B0, 0, 0); PG8_SCHED; PG8_LDA(At, 0, 0); PG8_STAGE(PG8_SA(1, 1), a1 + hstepA, voffA);
            PG8_WAIT_L(8); PG8_BAR; PG8_WAIT_L(0); PG8_MMA(0, 0, At, B0); PG8_BAR; PG8_SCHED;
            PG8_LDB(B1, 0, 1); PG8_STAGE(PG8_SB(0, 0), b2, voffB);
            PG8_BAR; PG8_WAIT_L(0); PG8_MMA(0, 1, At, B1); PG8_BAR;
            PG8_LDA(At, 0, 1); PG8_STAGE(PG8_SA(0, 0), a2, voffA);
            PG8_BAR; PG8_WAIT_L(0); PG8_MMA(1, 0, At, B0); PG8_BAR; PG8_SCHED;
            PG8_STAGE(PG8_SB(0, 1), b2 + hstep, voffB);
            PG8_WAIT_V(6); PG8_BAR; PG8_MMA(1, 1, At, B1); PG8_BAR;
            PG8_LDB(B0, 1, 0); PG8_SCHED; PG8_LDA(At, 1, 0); PG8_STAGE(PG8_SA(0, 1), a2 + hstepA, voffA);
            PG8_WAIT_L(8); PG8_BAR; PG8_WAIT_L(0); PG8_MMA(0, 0, At, B0); PG8_BAR; PG8_SCHED;
            PG8_LDB(B1, 1, 1); PG8_STAGE(PG8_SB(1, 0), b3, voffB);
            PG8_BAR; PG8_WAIT_L(0); PG8_MMA(0, 1, At, B1); PG8_BAR;
            PG8_LDA(At, 1, 1); PG8_STAGE(PG8_SA(1, 0), a3, voffA);
            PG8_BAR; PG8_WAIT_L(0); PG8_MMA(1, 0, At, B0); PG8_BAR; PG8_SCHED;
            PG8_STAGE(PG8_SB(1, 1), b3 + hstep, voffB);
            PG8_WAIT_V(6); PG8_BAR; PG8_MMA(1, 1, At, B1); PG8_BAR;
            }
        }
        if constexpr (ALIGN_EPI) { if (wr == 0) PG8_BAR; }
        if constexpr (!Epi::AFTER_DRAIN) { E(acc, cur, wr, wc, fr, fq); S.done(cur); }
        if (!has_next) break;
#pragma unroll
        for (int a = 0; a < 2; ++a)
#pragma unroll
            for (int b = 0; b < 2; ++b)
#pragma unroll
                for (int m = 0; m < 4; ++m)
#pragma unroll
                    for (int n = 0; n < 2; ++n) acc[a][b][m][n] = (f32x4){0.f, 0.f, 0.f, 0.f};
        cur = nxt; cA = nA; cB = nB; ++ui;
        if constexpr (ALIGN_EPI) { if (wr == 1) PG8_BAR; }
    }
    PG8_WAIT_V(0);
    if constexpr (!ALIGN_EPI) { if (wr == 0) PG8_BAR; }
    PG8_BAR;
    if constexpr (Epi::AFTER_DRAIN) { E.fused(acc, cur, wr, wc, fr, fq, lds, wid, lane); S.done(cur); }
#undef PG8_SA
#undef PG8_SB
#undef PG8_STAGE
#undef PG8_LDA
#undef PG8_LDB
#undef PG8_MMA
#undef PG8_WAIT_V
#undef PG8_WAIT_L
#undef PG8_BAR
#undef PG8_SCHED
}
}
using pg8::bf16_t; using pg8::f32x4; using pg8::u32x4; using pg8::bf16x8;
#define LAS __attribute__((address_space(3)))
typedef unsigned u32x2 __attribute__((ext_vector_type(2)));
typedef float f32x2v __attribute__((ext_vector_type(2)));
constexpr int DM = 1024, DIN = 8192, DMIX = 2048, T_ALL = 49152, MG = 16384, NGROUPS = 3, NH = 8, HD = 128;
constexpr float EPS = 1e-6f;
constexpr size_t MiB = 1u << 20;
constexpr size_t WS_CTL = 0, WS_OML = 1 * MiB, WS_WSB = 1 * MiB + 65536, WS_RS = 1 * MiB + 524288;
constexpr size_t WS_WIT = 2 * MiB, WS_WOT = 18 * MiB, WS_VSTAT = 22 * MiB, WS_OSTAT = 24 * MiB, WS_STATE = 26 * MiB, WS_DEC = 90 * MiB;
constexpr size_t WS_P = 92 * MiB, WS_MIX = 348 * MiB, WS_OF = 412 * MiB, WS_END = 476 * MiB;
constexpr size_t PSTRIDE = (size_t)MG * DM;
enum { PJ_U = 0, PJ_V = 1, PJ_ZA = 2, PJ_Q = 3, PJ_KF = 4, PJ_KB = 5, PJ_I = 6, PJ_ZB = 7 };

__device__ __forceinline__ unsigned f2bf(float f) { unsigned u = __float_as_uint(f); return (u + 0x7fffu + ((u >> 16) & 1u)) >> 16; }
__device__ __forceinline__ float bf2f(unsigned b) { return __uint_as_float(b << 16); }
__device__ __forceinline__ float bflo(unsigned w) { return __uint_as_float(w << 16); }
__device__ __forceinline__ float bfhi(unsigned w) { return __uint_as_float(w & 0xffff0000u); }
__device__ __forceinline__ unsigned pk2(float lo, float hi) { return pg8::cvt_pk_bf16(lo, hi); }
__device__ __forceinline__ float wave_sum(float v) {
#pragma unroll
    for (int o = 1; o < 64; o <<= 1) v += __shfl_xor(v, o);
    return v;
}
__device__ __forceinline__ int opaque_tid() { int t = threadIdx.x; asm volatile("" : "+v"(t)); return t; }
__device__ __forceinline__ float fast_rcp(float x) { return __builtin_amdgcn_rcpf(x); }
__device__ __forceinline__ float silu_f(float z) { return z * fast_rcp(1.0f + __expf(-z)); }

struct Params {
    const float* x_prompt; const float* x_sample; const float* norm_g; const float* w_in; const float* ln_v_g; const float* ln_v_b;
    const float* w_s; const float* b_s; const float* lb_params; const float* gn_g; const float* w_out; const float* final_g;
    float* out; unsigned char* ws;
};
__device__ __forceinline__ const float* x_row(const Params& p, int tok) { return tok < 32768 ? p.x_prompt + (size_t)tok * DM : p.x_sample + (size_t)(tok - 32768) * DM; }
__device__ __forceinline__ bf16_t* xb_row(const Params& p, int tok) { return (bf16_t*)((unsigned char*)p.out + (size_t)tok * 4096 + 2048); }

namespace pg8 {
struct EpiIn {
    static constexpr bool PERM = true, AFTER_DRAIN = false;
    bf16_t* P; const float* rs; const float* oml; float* vstat;
    __device__ __forceinline__ void operator()(const f32x4 (&acc)[2][2][4][2], const Unit& u, int wr, int wc, int fr, int fq) const {
        const int grp = u.pn >> 2;
        const int row0 = u.pm * BM + wr * 64 + fr;
        const int colt = (u.pn & 3) * BM + wc * 32 + 8 * fq;
        bf16_t* base = P + (size_t)grp * PSTRIDE + colt;
        float rsv[2][4];
#pragma unroll
        for (int ai = 0; ai < 2; ++ai)
#pragma unroll
            for (int m = 0; m < 4; ++m) rsv[ai][m] = rs[row0 + ai * HALF + m * 16];
        if (grp == PJ_KF || grp == PJ_KB) {
            const float* om = oml + (grp - PJ_KF) * DM + colt;
            f32x4 o[2][2];
#pragma unroll
            for (int bj = 0; bj < 2; ++bj)
#pragma unroll
                for (int n = 0; n < 2; ++n) o[bj][n] = *(const f32x4*)(om + bj * HALF + 4 * n);
#pragma unroll
            for (int ai = 0; ai < 2; ++ai)
#pragma unroll
                for (int m = 0; m < 4; ++m) { bf16_t* rowp = base + (size_t)(row0 + ai * HALF + m * 16) * DM;
#pragma unroll
                    for (int bj = 0; bj < 2; ++bj) { f32x4 v0 = acc[ai][bj][m][0] * rsv[ai][m], v1 = acc[ai][bj][m][1] * rsv[ai][m];
#pragma unroll
                        for (int j = 0; j < 4; ++j) { v0[j] = o[bj][0][j] * fast_rcp(1.0f + __expf(v0[j])); v1[j] = o[bj][1][j] * fast_rcp(1.0f + __expf(v1[j])); }
                        u32x4 w; w.x = cvt_pk_bf16(v0[0], v0[1]); w.y = cvt_pk_bf16(v0[2], v0[3]); w.z = cvt_pk_bf16(v1[0], v1[1]); w.w = cvt_pk_bf16(v1[2], v1[3]);
                        *(u32x4*)(rowp + bj * HALF) = w; } }
        } else if (grp == PJ_ZA || grp == PJ_Q || grp == PJ_ZB) {
#pragma unroll
            for (int ai = 0; ai < 2; ++ai)
#pragma unroll
                for (int m = 0; m < 4; ++m) { bf16_t* rowp = base + (size_t)(row0 + ai * HALF + m * 16) * DM;
#pragma unroll
                    for (int bj = 0; bj < 2; ++bj) { f32x4 v0 = acc[ai][bj][m][0] * rsv[ai][m], v1 = acc[ai][bj][m][1] * rsv[ai][m];
#pragma unroll
                        for (int j = 0; j < 4; ++j) { v0[j] = silu_f(v0[j]); v1[j] = silu_f(v1[j]); }
                        u32x4 w; w.x = cvt_pk_bf16(v0[0], v0[1]); w.y = cvt_pk_bf16(v0[2], v0[3]); w.z = cvt_pk_bf16(v1[0], v1[1]); w.w = cvt_pk_bf16(v1[2], v1[3]);
                        *(u32x4*)(rowp + bj * HALF) = w; } }
        } else {
#pragma unroll
            for (int ai = 0; ai < 2; ++ai)
#pragma unroll
                for (int m = 0; m < 4; ++m) { const int row = row0 + ai * HALF + m * 16; bf16_t* rowp = base + (size_t)row * DM; float s = 0.f, q = 0.f;
#pragma unroll
                    for (int bj = 0; bj < 2; ++bj) { const f32x4 v0 = acc[ai][bj][m][0] * rsv[ai][m], v1 = acc[ai][bj][m][1] * rsv[ai][m];
                        s += ((v0[0] + v0[1]) + (v0[2] + v0[3])) + ((v1[0] + v1[1]) + (v1[2] + v1[3]));
                        q += ((v0[0] * v0[0] + v0[1] * v0[1]) + (v0[2] * v0[2] + v0[3] * v0[3])) + ((v1[0] * v1[0] + v1[1] * v1[1]) + (v1[2] * v1[2] + v1[3] * v1[3]));
                        u32x4 w; w.x = cvt_pk_bf16(v0[0], v0[1]); w.y = cvt_pk_bf16(v0[2], v0[3]); w.z = cvt_pk_bf16(v1[0], v1[1]); w.w = cvt_pk_bf16(v1[2], v1[3]);
                        *(u32x4*)(rowp + bj * HALF) = w; }
                    if (grp == PJ_V) { s += __shfl_xor(s, 16); s += __shfl_xor(s, 32); q += __shfl_xor(q, 16); q += __shfl_xor(q, 32);
                        if (fq == 0) *(f32x2v*)(vstat + (size_t)row * 32 + ((u.pn & 3) * 4 + wc) * 2) = (f32x2v){s, q}; } }
        }
    }
};
struct EpiOut {
    static constexpr bool PERM = false, AFTER_DRAIN = false;
    const float* xg; float* out; float* ostat;
    __device__ __forceinline__ void operator()(const f32x4 (&acc)[2][2][4][2], const Unit& u, int wr, int wc, int fr, int fq) const {
        const int row0 = u.pm * BM + wr * 64 + fr, col0 = u.pn * BM + wc * 32 + 4 * fq;
#pragma unroll
        for (int ai = 0; ai < 2; ++ai)
#pragma unroll
            for (int m = 0; m < 4; ++m) { const int row = row0 + ai * HALF + m * 16; const size_t off = (size_t)row * DM + col0; float q = 0.f;
#pragma unroll
                for (int bj = 0; bj < 2; ++bj)
#pragma unroll
                    for (int n = 0; n < 2; ++n) { const f32x4 r = *(const f32x4*)(xg + off + bj * HALF + n * 16) + acc[ai][bj][m][n];
                        q += (r[0] * r[0] + r[1] * r[1]) + (r[2] * r[2] + r[3] * r[3]); *(f32x4*)(out + off + bj * HALF + n * 16) = r; }
                q += __shfl_xor(q, 16); q += __shfl_xor(q, 32);
                if (fq == 0) ostat[(size_t)row * 16 + u.pn * 4 + wc] = q; }
    }
};
}
constexpr int LDS_BYTES = 147456;
extern __shared__ __attribute__((aligned(16))) unsigned char lds_raw[];

__device__ __forceinline__ void transpose_item(const float* W, int K, int N, const float* gk, bf16_t* WT, LAS float* scr, int item, int lane) {
    const int nblk = N / 32, kb = item / nblk, nb = item % nblk, k0 = 64 * kb, n0 = 32 * nb;
#pragma unroll 8
    for (int i = 0; i < 32; ++i) { const int kk = 2 * i + (lane >> 5); float w = W[(size_t)(k0 + kk) * N + n0 + (lane & 31)]; if (gk) w *= gk[k0 + kk]; scr[kk * 33 + (lane & 31)] = w; }
    asm volatile("s_waitcnt lgkmcnt(0)" ::: "memory");
    const int c = lane & 7;
#pragma unroll
    for (int j = 0; j < 4; ++j) { const int n = (lane >> 3) + 8 * j; const LAS float* s = scr + (8 * c) * 33 + n;
        u32x4 o; o.x = pk2(s[0 * 33], s[1 * 33]); o.y = pk2(s[2 * 33], s[3 * 33]); o.z = pk2(s[4 * 33], s[5 * 33]); o.w = pk2(s[6 * 33], s[7 * 33]);
        *(u32x4*)(WT + (size_t)(n0 + n) * K + k0 + 8 * c) = o; }
    asm volatile("s_waitcnt lgkmcnt(0)" ::: "memory");
}
__device__ __forceinline__ void phase_prologue(const Params& p, LAS unsigned char* lds) {
    const int tid = opaque_tid(), lane = tid & 63, wave = tid >> 6, nw = blockDim.x >> 6;
    const int gw = blockIdx.x * nw + wave, NGW = gridDim.x * nw;
    LAS float* scr = (LAS float*)(lds + wave * 16384);
    bf16_t* wit = (bf16_t*)(p.ws + WS_WIT); bf16_t* wot = (bf16_t*)(p.ws + WS_WOT);
    constexpr int I_IN = (DM / 64) * (DIN / 32), I_OUT = (DMIX / 64) * (DM / 32);
    for (int it = gw; it < I_IN + I_OUT; it += NGW) {
        if (it < I_IN) transpose_item(p.w_in, DM, DIN, p.norm_g, wit, scr, it, lane);
        else transpose_item(p.w_out, DMIX, DM, nullptr, wot, scr, it - I_IN, lane);
    }
    const int gt = blockIdx.x * blockDim.x + tid, NGT = gridDim.x * blockDim.x;
    bf16_t* wsb = (bf16_t*)(p.ws + WS_WSB);
    for (int i = gt; i < NH * 128 * 128; i += NGT) wsb[i] = (bf16_t)f2bf(p.w_s[i]);
    float* oml = (float*)(p.ws + WS_OML);
    for (int i = gt; i < 2 * DM; i += NGT) { const int d = i / DM, c = i % DM; const float a = p.lb_params[(d * 2 + 0) * DM + c], b = p.lb_params[(d * 2 + 1) * DM + c];
        const float mx = fmaxf(a, b), ea = expf(a - mx), eb = expf(b - mx); oml[i] = eb / (ea + eb); }
    float* rs = (float*)(p.ws + WS_RS);
    for (int tok = gw; tok < T_ALL; tok += NGW) {
        const f32x4* xr = (const f32x4*)x_row(p, tok) + lane; f32x4 v[4]; float s = 0.f;
#pragma unroll
        for (int j = 0; j < 4; ++j) { v[j] = xr[64 * j]; s += (v[j][0] * v[j][0] + v[j][1] * v[j][1]) + (v[j][2] * v[j][2] + v[j][3] * v[j][3]); }
        s = wave_sum(s);
        if (lane == 0) rs[tok] = 1.0f / sqrtf(s * (1.0f / DM) + EPS);
        u32x2* o = (u32x2*)xb_row(p, tok) + lane;
#pragma unroll
        for (int j = 0; j < 4; ++j) o[64 * j] = (u32x2){pk2(v[j][0], v[j][1]), pk2(v[j][2], v[j][3])};
    }
}

__device__ __forceinline__ void phase_gemm_in(const Params& p, int g, LAS unsigned char* lds) {
    pg8::Gemm gm{xb_row(p, g * MG), (const bf16_t*)(p.ws + WS_WIT), MG, DIN, DM, 2 * DM};
    pg8::StaticOrder S; S.init(MG, DIN, gridDim.x, blockIdx.x);
    pg8::EpiIn E{(bf16_t*)(p.ws + WS_P), (const float*)(p.ws + WS_RS) + g * MG, (const float*)(p.ws + WS_OML), (float*)(p.ws + WS_VSTAT)};
    pg8::gemm_phase<pg8::EpiIn, pg8::StaticOrder, true, true>(lds, gm, S, E);
}
__device__ __forceinline__ void phase_gemm_out(const Params& p, int g, LAS unsigned char* lds) {
    pg8::Gemm gm{(const bf16_t*)(p.ws + WS_MIX), (const bf16_t*)(p.ws + WS_WOT), MG, DM, DMIX, DMIX};
    pg8::StaticOrder S; S.init(MG, DM, gridDim.x, blockIdx.x);
    pg8::EpiOut E{x_row(p, g * MG), p.out + (size_t)g * MG * DM, (float*)(p.ws + WS_OSTAT)};
    pg8::gemm_phase<pg8::EpiOut, pg8::StaticOrder, true, true>(lds, gm, S, E);
}
__device__ __forceinline__ void phase_final(const Params& p, int g) {
    const int tid = opaque_tid(), lane = tid & 63, wave = tid >> 6, nw = blockDim.x >> 6;
    const float* ostat = (const float*)(p.ws + WS_OSTAT);
    for (int row = blockIdx.x * nw + wave; row < MG; row += gridDim.x * nw) {
        float q = lane < 16 ? ostat[(size_t)row * 16 + lane] : 0.f; q = wave_sum(q);
        const float r = 1.0f / sqrtf(q * (1.0f / DM) + EPS);
        f32x4* o = (f32x4*)(p.out + ((size_t)g * MG + row) * DM) + lane; const f32x4* fg = (const f32x4*)p.final_g + lane;
#pragma unroll
        for (int j = 0; j < 4; ++j) o[64 * j] = o[64 * j] * r * fg[64 * j];
    }
}

__device__ __forceinline__ void phase_gmlp_simple(const Params& p, int g, LAS unsigned char* lds) {
    LAS float* vn = (LAS float*)lds; LAS float* mu = vn + 128 * 128; LAS float* rstd = mu + 128;
    const int tid = opaque_tid();
    const bf16_t* P = (const bf16_t*)(p.ws + WS_P); const float* vstat = (const float*)(p.ws + WS_VSTAT);
    bf16_t* mix = (bf16_t*)(p.ws + WS_MIX);
    for (int item = blockIdx.x; item < (MG / 128) * NH; item += gridDim.x) {
        const int chunk = item >> 3, h = item & 7, r0 = chunk * 128;
        __syncthreads();
        if (tid < 128) { float s = 0.f, q = 0.f; for (int i = 0; i < 16; ++i) { s += vstat[(size_t)(r0 + tid) * 32 + 2 * i]; q += vstat[(size_t)(r0 + tid) * 32 + 2 * i + 1]; }
            const float m = s * (1.0f / DM), var = q * (1.0f / DM) - m * m; mu[tid] = m; rstd[tid] = 1.0f / sqrtf(var + EPS); }
        __syncthreads();
        for (int idx = tid; idx < 128 * 128; idx += 512) { const int s = idx >> 7, c = idx & 127; const float v = bf2f(P[PJ_V * PSTRIDE + (size_t)(r0 + s) * DM + h * 128 + c]);
            vn[idx] = (v - mu[s]) * rstd[s] * p.ln_v_g[h * 128 + c] + p.ln_v_b[h * 128 + c]; }
        __syncthreads();
        const int c = tid & 127, t0 = (tid >> 7) * 32;
        for (int t = t0; t < t0 + 32; ++t) {
            const float* w = p.w_s + ((size_t)h * 128 + t) * 128; float acc = 0.f;
#pragma unroll 8
            for (int s = 0; s < 128; ++s) acc += w[s] * vn[s * 128 + c];
            acc += p.b_s[h * 128 + t];
            const size_t o = (size_t)(r0 + t) * DM + h * 128 + c;
            const float val = bf2f(P[PJ_U * PSTRIDE + o]) * acc * bf2f(P[PJ_ZA * PSTRIDE + o]);
            mix[(size_t)(r0 + t) * DMIX + h * 128 + c] = (bf16_t)f2bf(val);
        }
    }
}
__device__ __forceinline__ void phase_scan_simple(const Params& p, int g) {
    const int tid = opaque_tid(), lane = tid & 63, wave = tid >> 6;
    const int nseq = g < 2 ? 2 : 1, L = MG / nseq;
    const bf16_t* P = (const bf16_t*)(p.ws + WS_P);
    for (int item = wave * gridDim.x + blockIdx.x; item < nseq * 256; item += gridDim.x * (blockDim.x >> 6)) {
        const int vs = item & 15, dir = (item >> 4) & 1, h = (item >> 5) & 7, seq = item >> 8;
        float* O = (float*)(p.ws + (dir ? WS_STATE : WS_OF));
        float S0[8], S1[8];
#pragma unroll
        for (int j = 0; j < 8; ++j) { S0[j] = 0.f; S1[j] = 0.f; }
#pragma unroll 4
        for (int step = 0; step < L; ++step) {
            const int row = seq * L + (dir ? L - 1 - step : step);
            const size_t o = (size_t)row * DM + h * 128;
            const unsigned kw = *(const unsigned*)(P + (PJ_KF + dir) * PSTRIDE + o + 2 * lane);
            const unsigned qw = *(const unsigned*)(P + PJ_Q * PSTRIDE + o + 2 * lane);
            const u32x4 vw = *(const u32x4*)(P + PJ_I * PSTRIDE + o + vs * 8);
            const float k0 = bflo(kw), k1 = bfhi(kw), f0 = 1.0f - k0, f1 = 1.0f - k1, q0 = bflo(qw), q1 = bfhi(qw);
            float v[8] = {bflo(vw.x), bfhi(vw.x), bflo(vw.y), bfhi(vw.y), bflo(vw.z), bfhi(vw.z), bflo(vw.w), bfhi(vw.w)}, pr[8];
#pragma unroll
            for (int j = 0; j < 8; ++j) { S0[j] = f0 * S0[j] + k0 * v[j]; S1[j] = f1 * S1[j] + k1 * v[j]; pr[j] = S0[j] * q0 + S1[j] * q1; }
            float a4[4], a2[2], a1;
            { const bool hi = lane & 32;
#pragma unroll
              for (int i = 0; i < 4; ++i) { const float send = hi ? pr[i] : pr[4 + i]; const float keep = hi ? pr[4 + i] : pr[i]; a4[i] = keep + __shfl_xor(send, 32); } }
            { const bool hi = lane & 16;
#pragma unroll
              for (int i = 0; i < 2; ++i) { const float send = hi ? a4[i] : a4[2 + i]; const float keep = hi ? a4[2 + i] : a4[i]; a2[i] = keep + __shfl_xor(send, 16); } }
            { const bool hi = lane & 8; const float send = hi ? a2[0] : a2[1]; const float keep = hi ? a2[1] : a2[0]; a1 = keep + __shfl_xor(send, 8); }
            a1 += __shfl_xor(a1, 4); a1 += __shfl_xor(a1, 2); a1 += __shfl_xor(a1, 1);
            if ((lane & 7) == 0) O[o + vs * 8 + (lane >> 3)] = a1;
        }
    }
}
__device__ __forceinline__ void phase_hnorm(const Params& p, int g) {
    const int tid = opaque_tid(), lane = tid & 63, nw = blockDim.x >> 6;
    for (int item = blockIdx.x * nw + (tid >> 6); item < MG * NH; item += gridDim.x * nw) {
        const int row = item >> 3, h = item & 7;
        const size_t o = (size_t)row * DM + h * 128 + 2 * lane;
        const f32x2v a = *(const f32x2v*)((const float*)(p.ws + WS_OF) + o), b = *(const f32x2v*)((const float*)(p.ws + WS_STATE) + o);
        const float o0 = a.x + b.x, o1 = a.y + b.y; const float ss = wave_sum(o0 * o0 + o1 * o1);
        const float r = 1.0f / sqrtf(ss * (1.0f / 128.0f) + EPS);
        const unsigned zw = *(const unsigned*)((const bf16_t*)(p.ws + WS_P) + PJ_ZB * PSTRIDE + o);
        const float y0 = o0 * r * p.gn_g[h * 128 + 2 * lane] * bflo(zw), y1 = o1 * r * p.gn_g[h * 128 + 2 * lane + 1] * bfhi(zw);
        *(unsigned*)((bf16_t*)(p.ws + WS_MIX) + (size_t)row * DMIX + DM + h * 128 + 2 * lane) = pk2(y0, y1);
    }
}

namespace cg = cooperative_groups;
__global__ void __launch_bounds__(512, 2) k_mega(Params p) {
    cg::grid_group grid = cg::this_grid();
    LAS unsigned char* lds = (LAS unsigned char*)lds_raw;
    phase_prologue(p, lds);
    grid.sync();
    for (int g = 0; g < NGROUPS; ++g) {
        phase_gemm_in(p, g, lds);
        grid.sync();
        phase_gmlp_simple(p, g, lds);
        phase_scan_simple(p, g);
        grid.sync();
        phase_hnorm(p, g);
        grid.sync();
        phase_gemm_out(p, g, lds);
        grid.sync();
        phase_final(p, g);
    }
}

extern "C" void kernel_launch(void* const* d_in, const int* in_sizes, int n_in, void* d_out, int out_size, void* d_ws, size_t ws_size, hipStream_t stream) {
    static int grid = 0;
    if (grid == 0) {
        if (n_in != 12 || out_size != T_ALL * DM || ws_size < WS_END) { fprintf(stderr, "kernel_launch: unexpected shapes (n_in %d out %d ws %zu)\n", n_in, out_size, ws_size); grid = -1; return; }
        int dev = 0, cus = 0, per_cu = 0;
        if (hipGetDevice(&dev) != hipSuccess || hipDeviceGetAttribute(&cus, hipDeviceAttributeMultiprocessorCount, dev) != hipSuccess) { grid = -1; return; }
        if (hipFuncSetAttribute((const void*)k_mega, hipFuncAttributeMaxDynamicSharedMemorySize, LDS_BYTES) != hipSuccess) { fprintf(stderr, "kernel_launch: hipFuncSetAttribute failed\n"); grid = -1; return; }
        if (hipOccupancyMaxActiveBlocksPerMultiprocessor(&per_cu, (const void*)k_mega, 512, LDS_BYTES) != hipSuccess || per_cu < 1) { fprintf(stderr, "kernel_launch: occupancy query failed (%d)\n", per_cu); grid = -1; return; }
        grid = cus;
    }
    if (grid < 0) return;
    Params p{};
    p.x_prompt = (const float*)d_in[0]; p.x_sample = (const float*)d_in[1]; p.norm_g = (const float*)d_in[2]; p.w_in = (const float*)d_in[3];
    p.ln_v_g = (const float*)d_in[4]; p.ln_v_b = (const float*)d_in[5]; p.w_s = (const float*)d_in[6]; p.b_s = (const float*)d_in[7];
    p.lb_params = (const float*)d_in[8]; p.gn_g = (const float*)d_in[9]; p.w_out = (const float*)d_in[10]; p.final_g = (const float*)d_in[11];
    p.out = (float*)d_out; p.ws = (unsigned char*)d_ws;
    void* args[] = {&p};
    hipError_t e = hipLaunchCooperativeKernel((const void*)k_mega, dim3(grid), dim3(512), args, LDS_BYTES, stream);
    if (e != hipSuccess) fprintf(stderr, "kernel_launch: cooperative launch failed: %s (grid %d)\n", hipGetErrorString(e), grid);
}
```

```cpp
#include <hip/hip_runtime.h>
#include <hip/hip_cooperative_groups.h>
#include <cstdio>
#include <cstdint>
namespace pg8 {
#define PG8_LAS __attribute__((address_space(3)))
typedef unsigned short bf16_t;
typedef short bf16x8 __attribute__((ext_vector_type(8)));
typedef float f32x4 __attribute__((ext_vector_type(4)));
typedef unsigned u32x4 __attribute__((ext_vector_type(4)));
constexpr int BM = 256, BK = 64, HALF = 128, HTB = HALF * BK * 2  , STAGE_BYTES = 8 * HTB, NXCD = 8, WGM = 8;

__host__ __device__ __forceinline__ int lds_byte(int r, int c) { const int st = (r >> 4) * 2 + (c >> 5), rr = r & 15, cc = c & 31, ob = rr * 64 + cc * 2; return st * 1024 + (ob ^ (((ob >> 9) & 1) << 5)); }
__host__ __device__ __forceinline__ void stage_rc(int b, int& R, int& C) { const int st = b / 1024, sb = b % 1024, swz = sb ^ (((sb >> 9) & 1) << 5); R = (st >> 1) * 16 + swz / 64; C = (st & 1) * 32 + (swz % 64) / 2; }
__host__ __device__ __forceinline__ int perm32(int rho) { const int n = rho >> 4, i = rho & 15; return 8 * (i >> 2) + 4 * n + (i & 3); }

struct Unit { int pm, pn; };
struct Gemm { const bf16_t* A; const bf16_t* Bt; int M, N, K, lda; };

struct StaticOrder {
    int nM, nN, nwg, G, c;
    __host__ __device__ void init(int M, int N, int G_, int c_) { nM = M / BM; nN = N / BM; nwg = nM * nN; G = G_; c = c_; }
    __host__ __device__ bool next(int i, Unit& u) const {
        const long L = (long)i * G + c; if (L >= nwg) return false;
        int wgid = (int)L; { const int q = nwg / NXCD, r = nwg % NXCD, xcd = wgid % NXCD, off = wgid / NXCD; wgid = (xcd < r ? xcd * (q + 1) : r * (q + 1) + (xcd - r) * q) + off; }
        const int nig = WGM * nN, gid = wgid / nig, fm = gid * WGM, gsz = (nM - fm) < WGM ? (nM - fm) : WGM;
        u.pm = fm + ((wgid % nig) % gsz); u.pn = (wgid % nig) / gsz; return true;
    }
    __device__ __forceinline__ void a_ready(const Unit&) const {}
    __device__ __forceinline__ void done(const Unit&) const {}
};
__device__ __forceinline__ unsigned cvt_pk_bf16(float lo, float hi) { unsigned r; asm volatile("v_cvt_pk_bf16_f32 %0, %1, %2" : "=v"(r) : "v"(lo), "v"(hi)); return r; }
typedef float f32x2 __attribute__((ext_vector_type(2)));

template <class Epi, class Sched, bool ALIGN_EPI = false, bool SP2 = false>
__device__ __forceinline__ void gemm_phase(PG8_LAS unsigned char* lds, const Gemm g, const Sched& S, const Epi& E) {
    int tid_ = threadIdx.x; asm volatile("" : "+v"(tid_));
    const int tid = tid_, wid = __builtin_amdgcn_readfirstlane(tid >> 6), lane = tid & 63, wr = wid >> 2, wc = wid & 3, fr = lane & 15, fq = lane >> 4;
    const int K = g.K, nt = K / BK;
    unsigned voffA[2], voffB[2];
#pragma unroll
    for (int i = 0; i < 2; ++i) { int R, C; stage_rc(tid * 16 + i * 8192, R, C); const int Rb = Epi::PERM ? ((R & ~31) + perm32(R & 31)) : R;
        voffA[i] = (unsigned)(R * g.lda + C) * 2u; voffB[i] = (unsigned)(Rb * K + C) * 2u; }
    const size_t kstep = (size_t)(BK * 2);
    const size_t hstep = (size_t)HALF * K * 2, hstepA = (size_t)HALF * g.lda * 2;
    const size_t tstep = 2 * hstep, tstepA = 2 * hstepA;
    const unsigned ldsw = (unsigned)wid * 1024u;
    const int aoff = lds_byte(wr * 64 + fr, fq * 8), boff = lds_byte(wc * 32 + fr, fq * 8);
#define PG8_SA(b, h) (((b) * 2 + (h)) * HTB)
#define PG8_SB(b, h) ((4 + (b) * 2 + (h)) * HTB)
#define PG8_STAGE(bufoff, gbase, voff) do { _Pragma("unroll") for (int _i = 0; _i < 2; ++_i) \
        __builtin_amdgcn_global_load_lds((const unsigned*)((const char*)(gbase) + (voff)[_i]), (PG8_LAS unsigned*)(lds + (bufoff) + ldsw + _i * 8192), 16, 0, 0); } while (0)
#define PG8_LDA(dst, b, h) do { _Pragma("unroll") for (int m = 0; m < 4; ++m) _Pragma("unroll") for (int k = 0; k < 2; ++k) dst[m][k] = *(const PG8_LAS bf16x8*)(lds + PG8_SA(b, h) + aoff + m * 2048 + k * 1024); } while (0)
#define PG8_LDB(dst, b, h) do { _Pragma("unroll") for (int n = 0; n < 2; ++n) _Pragma("unroll") for (int k = 0; k < 2; ++k) dst[n][k] = *(const PG8_LAS bf16x8*)(lds + PG8_SB(b, h) + boff + n * 2048 + k * 1024); } while (0)
#define PG8_MMA(ai, bj, At, Bt) do { __builtin_amdgcn_s_setprio(1); _Pragma("unroll") for (int m = 0; m < 4; ++m) _Pragma("unroll") for (int n = 0; n < 2; ++n) _Pragma("unroll") for (int k = 0; k < 2; ++k) \
        acc[ai][bj][m][n] = __builtin_amdgcn_mfma_f32_16x16x32_bf16(Bt[n][k], At[m][k], acc[ai][bj][m][n], 0, 0, 0); __builtin_amdgcn_s_setprio(0); } while (0)
#define PG8_WAIT_V(n) asm volatile("s_waitcnt vmcnt(" #n ")" ::: "memory")
#define PG8_WAIT_L(n) asm volatile("s_waitcnt lgkmcnt(" #n ")" ::: "memory")
#define PG8_BAR __builtin_amdgcn_s_barrier()
#define PG8_SCHED __builtin_amdgcn_sched_barrier(0)
    Unit cur, nxt; int ui = 0;
    if (!S.next(0, cur)) return;
    f32x4 acc[2][2][4][2];
#pragma unroll
    for (int a = 0; a < 2; ++a)
#pragma unroll
        for (int b = 0; b < 2; ++b)
#pragma unroll
            for (int m = 0; m < 4; ++m)
#pragma unroll
                for (int n = 0; n < 2; ++n) acc[a][b][m][n] = (f32x4){0.f, 0.f, 0.f, 0.f};
    bf16x8 At[4][2], B0[2][2], B1[2][2];
    const char* cA = (const char*)g.A + (size_t)cur.pm * tstepA; const char* cB = (const char*)g.Bt + (size_t)cur.pn * tstep;
    S.a_ready(cur);
    if constexpr (SP2) {
        PG8_STAGE(PG8_SB(0, 0), cB, voffB); PG8_STAGE(PG8_SB(0, 1), cB + hstep, voffB); PG8_STAGE(PG8_SA(0, 0), cA, voffA); PG8_STAGE(PG8_SA(0, 1), cA + hstepA, voffA);
        if (wr == 1) PG8_BAR;
        PG8_WAIT_V(2); PG8_BAR;
        PG8_STAGE(PG8_SB(1, 0), cB + kstep, voffB); PG8_STAGE(PG8_SA(1, 0), cA + kstep, voffA); PG8_STAGE(PG8_SB(1, 1), cB + hstep + kstep, voffB);
        PG8_WAIT_V(6); PG8_BAR;
    } else {
        PG8_STAGE(PG8_SB(0, 0), cB, voffB); PG8_STAGE(PG8_SA(0, 0), cA, voffA); PG8_STAGE(PG8_SB(0, 1), cB + hstep, voffB); PG8_STAGE(PG8_SA(0, 1), cA + hstepA, voffA);
        if (wr == 1) PG8_BAR;
        PG8_WAIT_V(4); PG8_BAR;
        PG8_STAGE(PG8_SB(1, 0), cB + kstep, voffB); PG8_STAGE(PG8_SA(1, 0), cA + kstep, voffA); PG8_STAGE(PG8_SB(1, 1), cB + hstep + kstep, voffB);
        PG8_WAIT_V(6); PG8_BAR;
    }
    for (;;) {
        const bool has_next = S.next(ui + 1, nxt);
        const char* nA = has_next ? (const char*)g.A + (size_t)nxt.pm * tstepA : cA; const char* nB = has_next ? (const char*)g.Bt + (size_t)nxt.pn * tstep : cB;
        for (int t = 0; t < nt; t += 2) {
            const bool last = (t == nt - 2);
            const char* a1 = cA + (size_t)(t + 1) * kstep;
            const char* a2 = last ? nA : cA + (size_t)(t + 2) * kstep; const char* b2 = last ? nB : cB + (size_t)(t + 2) * kstep;
            const char* a3 = a2 + kstep; const char* b3 = b2 + kstep;
            if (last && has_next) S.a_ready(nxt);
            if constexpr (SP2) {
            PG8_LDB(B0, 0, 0); PG8_LDB(B1, 0, 1); PG8_SCHED; PG8_LDA(At, 0, 0); PG8_STAGE(PG8_SA(1, 1), a1 + hstepA, voffA);
            PG8_WAIT_V(8); PG8_WAIT_L(0); PG8_BAR; PG8_MMA(0, 0, At, B0); PG8_MMA(0, 1, At, B1); PG8_BAR; PG8_SCHED;
            PG8_LDA(At, 0, 1); PG8_STAGE(PG8_SB(0, 0), b2, voffB); PG8_STAGE(PG8_SB(0, 1), b2 + hstep, voffB); PG8_STAGE(PG8_SA(0, 0), a2, voffA);
            PG8_WAIT_V(8); PG8_WAIT_L(0); PG8_BAR; PG8_MMA(1, 0, At, B0); PG8_MMA(1, 1, At, B1); PG8_BAR; PG8_SCHED;
            PG8_LDB(B0, 1, 0); PG8_LDB(B1, 1, 1); PG8_SCHED; PG8_LDA(At, 1, 0); PG8_STAGE(PG8_SA(0, 1), a2 + hstepA, voffA);
            PG8_WAIT_V(8); PG8_WAIT_L(0); PG8_BAR; PG8_MMA(0, 0, At, B0); PG8_MMA(0, 1, At, B1); PG8_BAR; PG8_SCHED;
            PG8_LDA(At, 1, 1); PG8_STAGE(PG8_SB(1, 0), b3, voffB); PG8_STAGE(PG8_SB(1, 1), b3 + hstep, voffB); PG8_STAGE(PG8_SA(1, 0), a3, voffA);
            PG8_WAIT_V(8); PG8_WAIT_L(0); PG8_BAR; PG8_MMA(1, 0, At, B0); PG8_MMA(1, 1, At, B1); PG8_BAR; PG8_SCHED;
            } else {
            PG8_LDB(B0, 0, 0); PG8_SCHED; PG8_LDA(At, 0, 0); PG8_STAGE(PG8_SA(1, 1), a1 + hstepA, voffA);
            PG8_WAIT_L(8); PG8_BAR; PG8_WAIT_L(0); PG8_MMA(0, 0, At, B0); PG8_BAR; PG8_SCHED;
            PG8_LDB(B1, 0, 1); PG8_STAGE(PG8_SB(0, 0), b2, voffB);
            PG8_BAR; PG8_WAIT_L(0); PG8_MMA(0, 1, At, B1); PG8_BAR;
            PG8_LDA(At, 0, 1); PG8_STAGE(PG8_SA(0, 0), a2, voffA);
            PG8_BAR; PG8_WAIT_L(0); PG8_MMA(1, 0, At, B0); PG8_BAR; PG8_SCHED;
            PG8_STAGE(PG8_SB(0, 1), b2 + hstep, voffB);
            PG8_WAIT_V(6); PG8_BAR; PG8_MMA(1, 1, At, B1); PG8_BAR;
            PG8_LDB(B0, 1, 0); PG8_SCHED; PG8_LDA(At, 1, 0); PG8_STAGE(PG8_SA(0, 1), a2 + hstepA, voffA);
            PG8_WAIT_L(8); PG8_BAR; PG8_WAIT_L(0); PG8_MMA(0, 0, At, B0); PG8_BAR; PG8_SCHED;
            PG8_LDB(B1, 1, 1); PG8_STAGE(PG8_SB(1, 0), b3, voffB);
            PG8_BAR; PG8_WAIT_L(0); PG8_MMA(0, 1, At, B1); PG8_BAR;
            PG8_LDA(At, 1, 1); PG8_STAGE(PG8_SA(1, 0), a3, voffA);
            PG8_BAR; PG8_WAIT_L(0); PG8_MMA(1, 0, At, B0); PG8_BAR; PG8_SCHED;
            PG8_STAGE(PG8_SB(1, 1), b3 + hstep, voffB);
            PG8_WAIT_V(6); PG8_BAR; PG8_MMA(1, 1, At, B1); PG8_BAR;
            }
        }
        if constexpr (ALIGN_EPI) { if (wr == 0) PG8_BAR; }
        if constexpr (!Epi::AFTER_DRAIN) { E(acc, cur, wr, wc, fr, fq); S.done(cur); }
        if (!has_next) break;
#pragma unroll
        for (int a = 0; a < 2; ++a)
#pragma unroll
            for (int b = 0; b < 2; ++b)
#pragma unroll
                for (int m = 0; m < 4; ++m)
#pragma unroll
                    for (int n = 0; n < 2; ++n) acc[a][b][m][n] = (f32x4){0.f, 0.f, 0.f, 0.f};
        cur = nxt; cA = nA; cB = nB; ++ui;
        if constexpr (ALIGN_EPI) { if (wr == 1) PG8_BAR; }
    }
    PG8_WAIT_V(0);
    if constexpr (!ALIGN_EPI) { if (wr == 0) PG8_BAR; }
    PG8_BAR;
    if constexpr (Epi::AFTER_DRAIN) { E.fused(acc, cur, wr, wc, fr, fq, lds, wid, lane); S.done(cur); }
#undef PG8_SA
#undef PG8_SB
#undef PG8_STAGE
#undef PG8_LDA
#undef PG8_LDB
#undef PG8_MMA
#undef PG8_WAIT_V
#undef PG8_WAIT_L
#undef PG8_BAR
#undef PG8_SCHED
}
}
using pg8::bf16_t; using pg8::f32x4; using pg8::u32x4; using pg8::bf16x8;
#define LAS __attribute__((address_space(3)))
typedef unsigned u32x2 __attribute__((ext_vector_type(2)));
typedef float f32x2v __attribute__((ext_vector_type(2)));
constexpr int DM = 1024, DIN = 8192, DMIX = 2048, T_ALL = 49152, MG = 16384, NGROUPS = 3, NH = 8, HD = 128;
constexpr float EPS = 1e-6f;
constexpr size_t MiB = 1u << 20;
constexpr size_t WS_CTL = 0, WS_OML = 1 * MiB, WS_WSB = 1 * MiB + 65536, WS_RS = 1 * MiB + 524288;
constexpr size_t WS_WIT = 2 * MiB, WS_WOT = 18 * MiB, WS_VSTAT = 22 * MiB, WS_OSTAT = 24 * MiB, WS_STATE = 26 * MiB, WS_DEC = 90 * MiB;
constexpr size_t WS_P = 92 * MiB, WS_MIX = 348 * MiB, WS_OF = 412 * MiB, WS_END = 476 * MiB;
constexpr size_t PSTRIDE = (size_t)MG * DM;
enum { PJ_U = 0, PJ_V = 1, PJ_ZA = 2, PJ_Q = 3, PJ_KF = 4, PJ_KB = 5, PJ_I = 6, PJ_ZB = 7 };

__device__ __forceinline__ unsigned f2bf(float f) { unsigned u = __float_as_uint(f); return (u + 0x7fffu + ((u >> 16) & 1u)) >> 16; }
__device__ __forceinline__ float bf2f(unsigned b) { return __uint_as_float(b << 16); }
__device__ __forceinline__ float bflo(unsigned w) { return __uint_as_float(w << 16); }
__device__ __forceinline__ float bfhi(unsigned w) { return __uint_as_float(w & 0xffff0000u); }
__device__ __forceinline__ unsigned pk2(float lo, float hi) { return pg8::cvt_pk_bf16(lo, hi); }
__device__ __forceinline__ float wave_sum(float v) {
#pragma unroll
    for (int o = 1; o < 64; o <<= 1) v += __shfl_xor(v, o);
    return v;
}
__device__ __forceinline__ int opaque_tid() { int t = threadIdx.x; asm volatile("" : "+v"(t)); return t; }
__device__ __forceinline__ float fast_rcp(float x) { return __builtin_amdgcn_rcpf(x); }
__device__ __forceinline__ float silu_f(float z) { return z * fast_rcp(1.0f + __expf(-z)); }

struct Params {
    const float* x_prompt; const float* x_sample; const float* norm_g; const float* w_in; const float* ln_v_g; const float* ln_v_b;
    const float* w_s; const float* b_s; const float* lb_params; const float* gn_g; const float* w_out; const float* final_g;
    float* out; unsigned char* ws;
};
__device__ __forceinline__ const float* x_row(const Params& p, int tok) { return tok < 32768 ? p.x_prompt + (size_t)tok * DM : p.x_sample + (size_t)(tok - 32768) * DM; }
__device__ __forceinline__ bf16_t* xb_row(const Params& p, int tok) { return (bf16_t*)((unsigned char*)p.out + (size_t)tok * 4096 + 2048); }

namespace pg8 {
struct EpiIn {
    static constexpr bool PERM = true, AFTER_DRAIN = false;
    bf16_t* P; const float* rs; const float* oml; float* vstat;
    __device__ __forceinline__ void operator()(const f32x4 (&acc)[2][2][4][2], const Unit& u, int wr, int wc, int fr, int fq) const {
        const int grp = u.pn >> 2;
        const int row0 = u.pm * BM + wr * 64 + fr;
        const int colt = (u.pn & 3) * BM + wc * 32 + 8 * fq;
        bf16_t* base = P + (size_t)grp * PSTRIDE + colt;
        float rsv[2][4];
#pragma unroll
        for (int ai = 0; ai < 2; ++ai)
#pragma unroll
            for (int m = 0; m < 4; ++m) rsv[ai][m] = rs[row0 + ai * HALF + m * 16];
        if (grp == PJ_KF || grp == PJ_KB) {
            const float* om = oml + (grp - PJ_KF) * DM + colt;
            f32x4 o[2][2];
#pragma unroll
            for (int bj = 0; bj < 2; ++bj)
#pragma unroll
                for (int n = 0; n < 2; ++n) o[bj][n] = *(const f32x4*)(om + bj * HALF + 4 * n);
#pragma unroll
            for (int ai = 0; ai < 2; ++ai)
#pragma unroll
                for (int m = 0; m < 4; ++m) { bf16_t* rowp = base + (size_t)(row0 + ai * HALF + m * 16) * DM;
#pragma unroll
                    for (int bj = 0; bj < 2; ++bj) { f32x4 v0 = acc[ai][bj][m][0] * rsv[ai][m], v1 = acc[ai][bj][m][1] * rsv[ai][m];
#pragma unroll
                        for (int j = 0; j < 4; ++j) { v0[j] = o[bj][0][j] * fast_rcp(1.0f + __expf(v0[j])); v1[j] = o[bj][1][j] * fast_rcp(1.0f + __expf(v1[j])); }
                        u32x4 w; w.x = cvt_pk_bf16(v0[0], v0[1]); w.y = cvt_pk_bf16(v0[2], v0[3]); w.z = cvt_pk_bf16(v1[0], v1[1]); w.w = cvt_pk_bf16(v1[2], v1[3]);
                        *(u32x4*)(rowp + bj * HALF) = w; } }
        } else if (grp == PJ_ZA || grp == PJ_Q || grp == PJ_ZB) {
#pragma unroll
            for (int ai = 0; ai < 2; ++ai)
#pragma unroll
                for (int m = 0; m < 4; ++m) { bf16_t* rowp = base + (size_t)(row0 + ai * HALF + m * 16) * DM;
#pragma unroll
                    for (int bj = 0; bj < 2; ++bj) { f32x4 v0 = acc[ai][bj][m][0] * rsv[ai][m], v1 = acc[ai][bj][m][1] * rsv[ai][m];
#pragma unroll
                        for (int j = 0; j < 4; ++j) { v0[j] = silu_f(v0[j]); v1[j] = silu_f(v1[j]); }
                        u32x4 w; w.x = cvt_pk_bf16(v0[0], v0[1]); w.y = cvt_pk_bf16(v0[2], v0[3]); w.z = cvt_pk_bf16(v1[0], v1[1]); w.w = cvt_pk_bf16(v1[2], v1[3]);
                        *(u32x4*)(rowp + bj * HALF) = w; } }
        } else {
#pragma unroll
            for (int ai = 0; ai < 2; ++ai)
#pragma unroll
                for (int m = 0; m < 4; ++m) { const int row = row0 + ai * HALF + m * 16; bf16_t* rowp = base + (size_t)row * DM; float s = 0.f, q = 0.f;
#pragma unroll
                    for (int bj = 0; bj < 2; ++bj) { const f32x4 v0 = acc[ai][bj][m][0] * rsv[ai][m], v1 = acc[ai][bj][m][1] * rsv[ai][m];
                        s += ((v0[0] + v0[1]) + (v0[2] + v0[3])) + ((v1[0] + v1[1]) + (v1[2] + v1[3]));
                        q += ((v0[0] * v0[0] + v0[1] * v0[1]) + (v0[2] * v0[2] + v0[3] * v0[3])) + ((v1[0] * v1[0] + v1[1] * v1[1]) + (v1[2] * v1[2] + v1[3] * v1[3]));
                        u32x4 w; w.x = cvt_pk_bf16(v0[0], v0[1]); w.y = cvt_pk_bf16(v0[2], v0[3]); w.z = cvt_pk_bf16(v1[0], v1[1]); w.w = cvt_pk_bf16(v1[2], v1[3]);
                        *(u32x4*)(rowp + bj * HALF) = w; }
                    if (grp == PJ_V) { s += __shfl_xor(s, 16); s += __shfl_xor(s, 32); q += __shfl_xor(q, 16); q += __shfl_xor(q, 32);
                        if (fq == 0) *(f32x2v*)(vstat + (size_t)row * 32 + ((u.pn & 3) * 4 + wc) * 2) = (f32x2v){s, q}; } }
        }
    }
};
struct EpiOut {
    static constexpr bool PERM = false, AFTER_DRAIN = false;
    const float* xg; float* out; float* ostat;
    __device__ __forceinline__ void operator()(const f32x4 (&acc)[2][2][4][2], const Unit& u, int wr, int wc, int fr, int fq) const {
        const int row0 = u.pm * BM + wr * 64 + fr, col0 = u.pn * BM + wc * 32 + 4 * fq;
#pragma unroll
        for (int ai = 0; ai < 2; ++ai)
#pragma unroll
            for (int m = 0; m < 4; ++m) { const int row = row0 + ai * HALF + m * 16; const size_t off = (size_t)row * DM + col0; float q = 0.f;
#pragma unroll
                for (int bj = 0; bj < 2; ++bj)
#pragma unroll
                    for (int n = 0; n < 2; ++n) { const f32x4 r = *(const f32x4*)(xg + off + bj * HALF + n * 16) + acc[ai][bj][m][n];
                        q += (r[0] * r[0] + r[1] * r[1]) + (r[2] * r[2] + r[3] * r[3]); *(f32x4*)(out + off + bj * HALF + n * 16) = r; }
                q += __shfl_xor(q, 16); q += __shfl_xor(q, 32);
                if (fq == 0) ostat[(size_t)row * 16 + u.pn * 4 + wc] = q; }
    }
};
}
constexpr int LDS_BYTES = 147456;
extern __shared__ __attribute__((aligned(16))) unsigned char lds_raw[];

__device__ __forceinline__ void transpose_item(const float* W, int K, int N, const float* gk, bf16_t* WT, LAS float* scr, int item, int lane) {
    const int nblk = N / 32, kb = item / nblk, nb = item % nblk, k0 = 64 * kb, n0 = 32 * nb;
#pragma unroll 8
    for (int i = 0; i < 32; ++i) { const int kk = 2 * i + (lane >> 5); float w = W[(size_t)(k0 + kk) * N + n0 + (lane & 31)]; if (gk) w *= gk[k0 + kk]; scr[kk * 33 + (lane & 31)] = w; }
    asm volatile("s_waitcnt lgkmcnt(0)" ::: "memory");
    const int c = lane & 7;
#pragma unroll
    for (int j = 0; j < 4; ++j) { const int n = (lane >> 3) + 8 * j; const LAS float* s = scr + (8 * c) * 33 + n;
        u32x4 o; o.x = pk2(s[0 * 33], s[1 * 33]); o.y = pk2(s[2 * 33], s[3 * 33]); o.z = pk2(s[4 * 33], s[5 * 33]); o.w = pk2(s[6 * 33], s[7 * 33]);
        *(u32x4*)(WT + (size_t)(n0 + n) * K + k0 + 8 * c) = o; }
    asm volatile("s_waitcnt lgkmcnt(0)" ::: "memory");
}
__device__ __forceinline__ void phase_prologue(const Params& p, LAS unsigned char* lds) {
    const int tid = opaque_tid(), lane = tid & 63, wave = tid >> 6, nw = blockDim.x >> 6;
    const int gw = blockIdx.x * nw + wave, NGW = gridDim.x * nw;
    LAS float* scr = (LAS float*)(lds + wave * 16384);
    bf16_t* wit = (bf16_t*)(p.ws + WS_WIT); bf16_t* wot = (bf16_t*)(p.ws + WS_WOT);
    constexpr int I_IN = (DM / 64) * (DIN / 32), I_OUT = (DMIX / 64) * (DM / 32);
    for (int it = gw; it < I_IN + I_OUT; it += NGW) {
        if (it < I_IN) transpose_item(p.w_in, DM, DIN, p.norm_g, wit, scr, it, lane);
        else transpose_item(p.w_out, DMIX, DM, nullptr, wot, scr, it - I_IN, lane);
    }
    const int gt = blockIdx.x * blockDim.x + tid, NGT = gridDim.x * blockDim.x;
    bf16_t* wsb = (bf16_t*)(p.ws + WS_WSB);
    for (int i = gt; i < NH * 128 * 128; i += NGT) wsb[i] = (bf16_t)f2bf(p.w_s[i]);
    float* oml = (float*)(p.ws + WS_OML);
    for (int i = gt; i < 2 * DM; i += NGT) { const int d = i / DM, c = i % DM; const float a = p.lb_params[(d * 2 + 0) * DM + c], b = p.lb_params[(d * 2 + 1) * DM + c];
        const float mx = fmaxf(a, b), ea = expf(a - mx), eb = expf(b - mx); oml[i] = eb / (ea + eb); }
    float* rs = (float*)(p.ws + WS_RS);
    for (int tok = gw; tok < T_ALL; tok += NGW) {
        const f32x4* xr = (const f32x4*)x_row(p, tok) + lane; f32x4 v[4]; float s = 0.f;
#pragma unroll
        for (int j = 0; j < 4; ++j) { v[j] = xr[64 * j]; s += (v[j][0] * v[j][0] + v[j][1] * v[j][1]) + (v[j][2] * v[j][2] + v[j][3] * v[j][3]); }
        s = wave_sum(s);
        if (lane == 0) rs[tok] = 1.0f / sqrtf(s * (1.0f / DM) + EPS);
        u32x2* o = (u32x2*)xb_row(p, tok) + lane;
#pragma unroll
        for (int j = 0; j < 4; ++j) o[64 * j] = (u32x2){pk2(v[j][0], v[j][1]), pk2(v[j][2], v[j][3])};
    }
}

__device__ __forceinline__ void phase_gemm_in(const Params& p, int g, LAS unsigned char* lds) {
    pg8::Gemm gm{xb_row(p, g * MG), (const bf16_t*)(p.ws + WS_WIT), MG, DIN, DM, 2 * DM};
    pg8::StaticOrder S; S.init(MG, DIN, gridDim.x, blockIdx.x);
    pg8::EpiIn E{(bf16_t*)(p.ws + WS_P), (const float*)(p.ws + WS_RS) + g * MG, (const float*)(p.ws + WS_OML), (float*)(p.ws + WS_VSTAT)};
    pg8::gemm_phase<pg8::EpiIn, pg8::StaticOrder, true, true>(lds, gm, S, E);
}
__device__ __forceinline__ void phase_gemm_out(const Params& p, int g, LAS unsigned char* lds) {
    pg8::Gemm gm{(const bf16_t*)(p.ws + WS_MIX), (const bf16_t*)(p.ws + WS_WOT), MG, DM, DMIX, DMIX};
    pg8::StaticOrder S; S.init(MG, DM, gridDim.x, blockIdx.x);
    pg8::EpiOut E{x_row(p, g * MG), p.out + (size_t)g * MG * DM, (float*)(p.ws + WS_OSTAT)};
    pg8::gemm_phase<pg8::EpiOut, pg8::StaticOrder, true, true>(lds, gm, S, E);
}
__device__ __forceinline__ void phase_final(const Params& p, int g) {
    const int tid = opaque_tid(), lane = tid & 63, wave = tid >> 6, nw = blockDim.x >> 6;
    const float* ostat = (const float*)(p.ws + WS_OSTAT);
    for (int row = blockIdx.x * nw + wave; row < MG; row += gridDim.x * nw) {
        float q = lane < 16 ? ostat[(size_t)row * 16 + lane] : 0.f; q = wave_sum(q);
        const float r = 1.0f / sqrtf(q * (1.0f / DM) + EPS);
        f32x4* o = (f32x4*)(p.out + ((size_t)g * MG + row) * DM) + lane; const f32x4* fg = (const f32x4*)p.final_g + lane;
#pragma unroll
        for (int j = 0; j < 4; ++j) o[64 * j] = o[64 * j] * r * fg[64 * j];
    }
}

__device__ __forceinline__ void phase_gmlp_simple(const Params& p, int g, LAS unsigned char* lds) {
    LAS float* vn = (LAS float*)lds; LAS float* mu = vn + 128 * 128; LAS float* rstd = mu + 128;
    const int tid = opaque_tid();
    const bf16_t* P = (const bf16_t*)(p.ws + WS_P); const float* vstat = (const float*)(p.ws + WS_VSTAT);
    bf16_t* mix = (bf16_t*)(p.ws + WS_MIX);
    for (int item = blockIdx.x; item < (MG / 128) * NH; item += gridDim.x) {
        const int chunk = item >> 3, h = item & 7, r0 = chunk * 128;
        __syncthreads();
        if (tid < 128) { float s = 0.f, q = 0.f; for (int i = 0; i < 16; ++i) { s += vstat[(size_t)(r0 + tid) * 32 + 2 * i]; q += vstat[(size_t)(r0 + tid) * 32 + 2 * i + 1]; }
            const float m = s * (1.0f / DM), var = q * (1.0f / DM) - m * m; mu[tid] = m; rstd[tid] = 1.0f / sqrtf(var + EPS); }
        __syncthreads();
        for (int idx = tid; idx < 128 * 128; idx += 512) { const int s = idx >> 7, c = idx & 127; const float v = bf2f(P[PJ_V * PSTRIDE + (size_t)(r0 + s) * DM + h * 128 + c]);
            vn[idx] = (v - mu[s]) * rstd[s] * p.ln_v_g[h * 128 + c] + p.ln_v_b[h * 128 + c]; }
        __syncthreads();
        const int c = tid & 127, t0 = (tid >> 7) * 32;
        for (int t = t0; t < t0 + 32; ++t) {
            const float* w = p.w_s + ((size_t)h * 128 + t) * 128; float acc = 0.f;
#pragma unroll 8
            for (int s = 0; s < 128; ++s) acc += w[s] * vn[s * 128 + c];
            acc += p.b_s[h * 128 + t];
            const size_t o = (size_t)(r0 + t) * DM + h * 128 + c;
            const float val = bf2f(P[PJ_U * PSTRIDE + o]) * acc * bf2f(P[PJ_ZA * PSTRIDE + o]);
            mix[(size_t)(r0 + t) * DMIX + h * 128 + c] = (bf16_t)f2bf(val);
        }
    }
}
__device__ __forceinline__ void phase_scan_simple(const Params& p, int g) {
    const int tid = opaque_tid(), lane = tid & 63, wave = tid >> 6;
    const int nseq = g < 2 ? 2 : 1, L = MG / nseq;
    const bf16_t* P = (const bf16_t*)(p.ws + WS_P);
    for (int item = wave * gridDim.x + blockIdx.x; item < nseq * 256; item += gridDim.x * (blockDim.x >> 6)) {
        const int vs = item & 15, dir = (item >> 4) & 1, h = (item >> 5) & 7, seq = item >> 8;
        float* O = (float*)(p.ws + (dir ? WS_STATE : WS_OF));
        float S0[8], S1[8];
#pragma unroll
        for (int j = 0; j < 8; ++j) { S0[j] = 0.f; S1[j] = 0.f; }
#pragma unroll 4
        for (int step = 0; step < L; ++step) {
            const int row = seq * L + (dir ? L - 1 - step : step);
            const size_t o = (size_t)row * DM + h * 128;
            const unsigned kw = *(const unsigned*)(P + (PJ_KF + dir) * PSTRIDE + o + 2 * lane);
            const unsigned qw = *(const unsigned*)(P + PJ_Q * PSTRIDE + o + 2 * lane);
            const u32x4 vw = *(const u32x4*)(P + PJ_I * PSTRIDE + o + vs * 8);
            const float k0 = bflo(kw), k1 = bfhi(kw), f0 = 1.0f - k0, f1 = 1.0f - k1, q0 = bflo(qw), q1 = bfhi(qw);
            float v[8] = {bflo(vw.x), bfhi(vw.x), bflo(vw.y), bfhi(vw.y), bflo(vw.z), bfhi(vw.z), bflo(vw.w), bfhi(vw.w)}, pr[8];
#pragma unroll
            for (int j = 0; j < 8; ++j) { S0[j] = f0 * S0[j] + k0 * v[j]; S1[j] = f1 * S1[j] + k1 * v[j]; pr[j] = S0[j] * q0 + S1[j] * q1; }
            float a4[4], a2[2], a1;
            { const bool hi = lane & 32;
#pragma unroll
              for (int i = 0; i < 4; ++i) { const float send = hi ? pr[i] : pr[4 + i]; const float keep = hi ? pr[4 + i] : pr[i]; a4[i] = keep + __shfl_xor(send, 32); } }
            { const bool hi = lane & 16;
#pragma unroll
              for (int i = 0; i < 2; ++i) { const float send = hi ? a4[i] : a4[2 + i]; const float keep = hi ? a4[2 + i] : a4[i]; a2[i] = keep + __shfl_xor(send, 16); } }
            { const bool hi = lane & 8; const float send = hi ? a2[0] : a2[1]; const float keep = hi ? a2[1] : a2[0]; a1 = keep + __shfl_xor(send, 8); }
            a1 += __shfl_xor(a1, 4); a1 += __shfl_xor(a1, 2); a1 += __shfl_xor(a1, 1);
            if ((lane & 7) == 0) O[o + vs * 8 + (lane >> 3)] = a1;
        }
    }
}
__device__ __forceinline__ void phase_hnorm(const Params& p, int g) {
    const int tid = opaque_tid(), lane = tid & 63, nw = blockDim.x >> 6;
    for (int item = blockIdx.x * nw + (tid >> 6); item < MG * NH; item += gridDim.x * nw) {
        const int row = item >> 3, h = item & 7;
        const size_t o = (size_t)row * DM + h * 128 + 2 * lane;
        const f32x2v a = *(const f32x2v*)((const float*)(p.ws + WS_OF) + o), b = *(const f32x2v*)((const float*)(p.ws + WS_STATE) + o);
        const float o0 = a.x + b.x, o1 = a.y + b.y; const float ss = wave_sum(o0 * o0 + o1 * o1);
        const float r = 1.0f / sqrtf(ss * (1.0f / 128.0f) + EPS);
        const unsigned zw = *(const unsigned*)((const bf16_t*)(p.ws + WS_P) + PJ_ZB * PSTRIDE + o);
        const float y0 = o0 * r * p.gn_g[h * 128 + 2 * lane] * bflo(zw), y1 = o1 * r * p.gn_g[h * 128 + 2 * lane + 1] * bfhi(zw);
        *(unsigned*)((bf16_t*)(p.ws + WS_MIX) + (size_t)row * DMIX + DM + h * 128 + 2 * lane) = pk2(y0, y1);
    }
}

typedef float f32x16 __attribute__((ext_vector_type(16)));
typedef short s16x4 __attribute__((ext_vector_type(4)));
typedef __bf16 bf16x2c __attribute__((ext_vector_type(2)));
#define MFMA32(a, b, c) __builtin_amdgcn_mfma_f32_32x32x16_bf16((a), (b), (c), 0, 0, 0)
__device__ __forceinline__ unsigned pk2c(float lo, float hi) { return __builtin_bit_cast(unsigned, __builtin_convertvector((f32x2v){lo, hi}, bf16x2c)); }
__device__ __forceinline__ int crow(int reg, int h) { return (reg & 3) + 8 * (reg >> 2) + 4 * h; }
constexpr int SC = 256, NSC = MG / SC;
constexpr int HALF_LDS = 73728;
constexpr int QT_OFF = 0, QT_STR = 272;
constexpr int KT_OFF = 64 * QT_STR, KT_STR = 144;
constexpr int VT_OFF = KT_OFF + 128 * KT_STR;
constexpr int AT_OFF = VT_OFF + 128 * KT_STR, AT_STR = 144;
constexpr int SEG_OFF = AT_OFF + 64 * AT_STR;
constexpr int EEND_OFF = SEG_OFF + 2048;
constexpr int NRM_OFF = EEND_OFF + 512;
static_assert(NRM_OFF + 1024 <= HALF_LDS && 2 * HALF_LDS <= LDS_BYTES, "scan LDS map");
constexpr size_t STATE_SZ = 128 * 128;

template <int MODE>
__device__ __forceinline__ void scan_sweep(const Params& p, LAS unsigned char* hl, int sc, int h, int dir, int hw, int lane, bool valid) {
    const int r = lane & 31, h_ = lane >> 5;
    const bf16_t* P = (const bf16_t*)(p.ws + WS_P);
    float* state = (float*)(p.ws + WS_STATE) + ((size_t)(sc * NH + h) * 2 + dir) * STATE_SZ;
    float* OF = (float*)(p.ws + WS_OF);
    f32x16 S[4];
#pragma unroll
    for (int m = 0; m < 4; ++m)
#pragma unroll
        for (int i = 0; i < 16; ++i) S[m][i] = (MODE != 0 && valid) ? state[(32 * m + crow(i, h_)) * 128 + 32 * hw + r] : 0.f;
    float dprod0 = 1.f, dprod1 = 1.f;
    const int sc0 = sc * SC;
    const int trb = KT_OFF + (8 * h_ + ((lane & 15) >> 2)) * KT_STR + (16 * ((lane >> 4) & 1) + 4 * (lane & 3)) * 2;
#pragma unroll 1
    for (int j = 0; j < 4; ++j) {
        const int base = sc0 + 64 * (dir ? 3 - j : j);
        {
            unsigned kw[16], vw[16], qw[16];
            const size_t colo = (size_t)h * 128 + 2 * lane;
#pragma unroll
            for (int i = 0; i < 16; ++i) { const int tau = 16 * hw + i; const size_t o = (size_t)(dir ? base + 63 - tau : base + tau) * DM + colo;
                kw[i] = valid ? *(const unsigned*)(P + (PJ_KF + dir) * PSTRIDE + o) : 0u; vw[i] = valid ? *(const unsigned*)(P + PJ_I * PSTRIDE + o) : 0u;
                if (MODE != 0) qw[i] = valid ? *(const unsigned*)(P + PJ_Q * PSTRIDE + o) : 0u; }
            float e0 = 1.f, e1 = 1.f;
#pragma unroll
            for (int i = 0; i < 16; ++i) { e0 *= 1.0f - bflo(kw[i]); e1 *= 1.0f - bfhi(kw[i]); }
            *(LAS f32x2v*)(hl + SEG_OFF + (hw * 128 + 2 * lane) * 4) = (f32x2v){e0, e1};
            __syncthreads();
            float off0 = 1.f, off1 = 1.f, tot0 = 1.f, tot1 = 1.f;
#pragma unroll
            for (int w = 0; w < 4; ++w) { const f32x2v sg = *(const LAS f32x2v*)(hl + SEG_OFF + (w * 128 + 2 * lane) * 4); if (w < hw) { off0 *= sg.x; off1 *= sg.y; } tot0 *= sg.x; tot1 *= sg.y; }
            if (hw == 0) *(LAS f32x2v*)(hl + EEND_OFF + 2 * lane * 4) = (f32x2v){tot0, tot1};
            dprod0 *= tot0; dprod1 *= tot1;
            e0 = off0; e1 = off1;
            unsigned kt0[8], kt1[8], vt0[8], vt1[8];
#pragma unroll
            for (int i2 = 0; i2 < 8; ++i2) {
                float ka[2], kb[2];
#pragma unroll
                for (int u = 0; u < 2; ++u) { const int i = 2 * i2 + u; const float k0 = bflo(kw[i]), k1 = bfhi(kw[i]);
                    e0 *= 1.0f - k0; e1 *= 1.0f - k1;
                    ka[u] = k0 * fast_rcp(e0); kb[u] = k1 * fast_rcp(e1);
                    if (MODE != 0) *(LAS unsigned*)(hl + QT_OFF + (16 * hw + i) * QT_STR + 4 * lane) = pk2c(bflo(qw[i]) * e0, bfhi(qw[i]) * e1); }
                kt0[i2] = pk2c(ka[0], ka[1]); kt1[i2] = pk2c(kb[0], kb[1]);
                vt0[i2] = (vw[2 * i2] & 0xffffu) | (vw[2 * i2 + 1] << 16); vt1[i2] = (vw[2 * i2] >> 16) | (vw[2 * i2 + 1] & 0xffff0000u);
            }
            LAS unsigned char* kp = hl + KT_OFF + (2 * lane) * KT_STR + 32 * hw; LAS unsigned char* vp = hl + VT_OFF + (2 * lane) * KT_STR + 32 * hw;
            *(LAS u32x4*)(kp) = (u32x4){kt0[0], kt0[1], kt0[2], kt0[3]}; *(LAS u32x4*)(kp + 16) = (u32x4){kt0[4], kt0[5], kt0[6], kt0[7]};
            *(LAS u32x4*)(kp + KT_STR) = (u32x4){kt1[0], kt1[1], kt1[2], kt1[3]}; *(LAS u32x4*)(kp + KT_STR + 16) = (u32x4){kt1[4], kt1[5], kt1[6], kt1[7]};
            *(LAS u32x4*)(vp) = (u32x4){vt0[0], vt0[1], vt0[2], vt0[3]}; *(LAS u32x4*)(vp + 16) = (u32x4){vt0[4], vt0[5], vt0[6], vt0[7]};
            *(LAS u32x4*)(vp + KT_STR) = (u32x4){vt1[0], vt1[1], vt1[2], vt1[3]}; *(LAS u32x4*)(vp + KT_STR + 16) = (u32x4){vt1[4], vt1[5], vt1[6], vt1[7]};
        }
        __syncthreads();
        f32x16 O[2];
        if (MODE != 0) {
            if (hw < 3) {
                const int si = hw >> 1, tj = (hw + 1) >> 1;
                f32x16 a;
#pragma unroll
                for (int i = 0; i < 16; ++i) a[i] = 0.f;
#pragma unroll
                for (int ks = 0; ks < 8; ++ks) {
                    LAS unsigned char* tp = hl + trb + ks * 16 * KT_STR + si * 64;
                    const s16x4 lo = __builtin_amdgcn_ds_read_tr16_b64_v4i16((LAS s16x4*)tp), hi = __builtin_amdgcn_ds_read_tr16_b64_v4i16((LAS s16x4*)(tp + 4 * KT_STR));
                    const bf16x8 af = __builtin_shufflevector(lo, hi, 0, 1, 2, 3, 4, 5, 6, 7);
                    const bf16x8 bq = *(const LAS bf16x8*)(hl + QT_OFF + (32 * tj + r) * QT_STR + ks * 32 + 16 * h_);
                    a = MFMA32(af, bq, a);
                }
#pragma unroll
                for (int g = 0; g < 4; ++g) { float x[4];
#pragma unroll
                    for (int e = 0; e < 4; ++e) { x[e] = a[4 * g + e]; if (si == tj && 8 * g + 4 * h_ + e > r) x[e] = 0.f; }
                    *(LAS u32x2*)(hl + AT_OFF + (32 * tj + r) * AT_STR + (32 * si + 8 * g + 4 * h_) * 2) = (u32x2){pk2c(x[0], x[1]), pk2c(x[2], x[3])}; }
            }
#pragma unroll
            for (int tj = 0; tj < 2; ++tj) { const int tau = 32 * tj + r; const size_t o = (size_t)(base + 63 - tau) * DM + h * 128 + 32 * hw + 4 * h_;
#pragma unroll
                for (int g = 0; g < 4; ++g) { f32x4 v = {0.f, 0.f, 0.f, 0.f}; if (MODE == 2 && valid) v = *(const f32x4*)(OF + o + 8 * g);
                    O[tj][4 * g] = v[0]; O[tj][4 * g + 1] = v[1]; O[tj][4 * g + 2] = v[2]; O[tj][4 * g + 3] = v[3]; } }
            __syncthreads();
        }
        bf16x8 vf[4];
#pragma unroll
        for (int ks = 0; ks < 4; ++ks) vf[ks] = *(const LAS bf16x8*)(hl + VT_OFF + (32 * hw + r) * KT_STR + ks * 32 + 16 * h_);
        if (MODE != 0) {
#pragma unroll
            for (int tj = 0; tj < 2; ++tj)
#pragma unroll
                for (int ks = 0; ks < 4; ++ks) if (tj == 1 || ks < 2) {
                    const bf16x8 ba = *(const LAS bf16x8*)(hl + AT_OFF + (32 * tj + r) * AT_STR + ks * 32 + 16 * h_);
                    O[tj] = MFMA32(vf[ks], ba, O[tj]); }
#pragma unroll
            for (int m = 0; m < 4; ++m)
#pragma unroll
                for (int s2 = 0; s2 < 2; ++s2) {
                    const u32x4 pa = {pk2c(S[m][8 * s2], S[m][8 * s2 + 1]), pk2c(S[m][8 * s2 + 2], S[m][8 * s2 + 3]), pk2c(S[m][8 * s2 + 4], S[m][8 * s2 + 5]), pk2c(S[m][8 * s2 + 6], S[m][8 * s2 + 7])};
                    const bf16x8 af = __builtin_bit_cast(bf16x8, pa);
#pragma unroll
                    for (int tj = 0; tj < 2; ++tj) { const LAS unsigned char* qp = hl + QT_OFF + (32 * tj + r) * QT_STR + (32 * m + 16 * s2 + 4 * h_) * 2;
                        const u32x2 b0 = *(const LAS u32x2*)qp, b1 = *(const LAS u32x2*)(qp + 16);
                        const bf16x8 bq = __builtin_bit_cast(bf16x8, ((u32x4){b0.x, b0.y, b1.x, b1.y}));
                        O[tj] = MFMA32(af, bq, O[tj]); }
                }
        }
#pragma unroll
        for (int m = 0; m < 4; ++m) {
#pragma unroll
            for (int ks = 0; ks < 4; ++ks) { const bf16x8 af = *(const LAS bf16x8*)(hl + KT_OFF + (32 * m + r) * KT_STR + ks * 32 + 16 * h_); S[m] = MFMA32(af, vf[ks], S[m]); }
#pragma unroll
            for (int g = 0; g < 4; ++g) { const f32x4 ee = *(const LAS f32x4*)(hl + EEND_OFF + (32 * m + 8 * g + 4 * h_) * 4);
                S[m][4 * g] *= ee[0]; S[m][4 * g + 1] *= ee[1]; S[m][4 * g + 2] *= ee[2]; S[m][4 * g + 3] *= ee[3]; }
        }
        if (MODE == 1) {
#pragma unroll
            for (int tj = 0; tj < 2; ++tj) { const size_t o = (size_t)(base + 32 * tj + r) * DM + h * 128 + 32 * hw + 4 * h_;
#pragma unroll
                for (int g = 0; g < 4; ++g) if (valid) *(f32x4*)(OF + o + 8 * g) = (f32x4){O[tj][4 * g], O[tj][4 * g + 1], O[tj][4 * g + 2], O[tj][4 * g + 3]}; }
        }
        if (MODE == 2) {
#pragma unroll
            for (int tj = 0; tj < 2; ++tj) { float ss = 0.f;
#pragma unroll
                for (int i = 0; i < 16; ++i) ss += O[tj][i] * O[tj][i];
                ss += __shfl_xor(ss, 32);
                if (h_ == 0) *(LAS float*)(hl + NRM_OFF + (hw * 64 + 32 * tj + r) * 4) = ss; }
            __syncthreads();
#pragma unroll
            for (int tj = 0; tj < 2; ++tj) { const int tau = 32 * tj + r; float tot = 0.f;
#pragma unroll
                for (int w = 0; w < 4; ++w) tot += *(const LAS float*)(hl + NRM_OFF + (w * 64 + tau) * 4);
                const float rinv = 1.0f / sqrtf(tot * (1.0f / 128.0f) + EPS);
                const int tok = base + 63 - tau, v0 = h * 128 + 32 * hw + 4 * h_;
#pragma unroll
                for (int g = 0; g < 4; ++g) if (valid) { const f32x4 gn = *(const f32x4*)(p.gn_g + v0 + 8 * g); const u32x2 zb = *(const u32x2*)(P + PJ_ZB * PSTRIDE + (size_t)tok * DM + v0 + 8 * g);
                    const float y0 = O[tj][4 * g] * rinv * gn[0] * bflo(zb.x), y1 = O[tj][4 * g + 1] * rinv * gn[1] * bfhi(zb.x), y2 = O[tj][4 * g + 2] * rinv * gn[2] * bflo(zb.y), y3 = O[tj][4 * g + 3] * rinv * gn[3] * bfhi(zb.y);
                    *(u32x2*)((bf16_t*)(p.ws + WS_MIX) + (size_t)tok * DMIX + DM + v0 + 8 * g) = (u32x2){pk2c(y0, y1), pk2c(y2, y3)}; } }
        } else {
            __syncthreads();
        }
    }
    if (MODE == 0 && valid) {
#pragma unroll
        for (int m = 0; m < 4; ++m)
#pragma unroll
            for (int i = 0; i < 16; ++i) state[(32 * m + crow(i, h_)) * 128 + 32 * hw + r] = S[m][i];
        if (hw == 0) *(f32x2v*)((float*)(p.ws + WS_DEC) + ((size_t)(sc * NH + h) * 2 + dir) * 128 + 2 * lane) = (f32x2v){dprod0, dprod1};
    }
}
constexpr int VN_OFF = 0, VN_STR = 272, GST_OFF = 128 * VN_STR;
static_assert(GST_OFF + 1024 <= HALF_LDS, "gmlp LDS map");
__device__ __forceinline__ void gmlp_item(const Params& p, LAS unsigned char* hl, int item, int hw, int lane, bool valid) {
    const int r = lane & 31, h_ = lane >> 5, chunk = item >> 3, h = item & 7, r0 = chunk * 128;
    const bf16_t* P = (const bf16_t*)(p.ws + WS_P);
    { const int s = hw * 64 + lane;
      if (s < 128) { float sm = 0.f, sq = 0.f;
          if (valid) { const f32x4* vs = (const f32x4*)((const float*)(p.ws + WS_VSTAT) + (size_t)(r0 + s) * 32);
#pragma unroll
              for (int i = 0; i < 8; ++i) { const f32x4 x = vs[i]; sm += x[0] + x[2]; sq += x[1] + x[3]; } }
          const float mean = sm * (1.0f / DM), var = sq * (1.0f / DM) - mean * mean;
          *(LAS float*)(hl + GST_OFF + s * 4) = mean; *(LAS float*)(hl + GST_OFF + 512 + s * 4) = 1.0f / sqrtf(var + EPS); } }
    __syncthreads();
    { const int c0 = h * 128 + 2 * lane; const float g0 = p.ln_v_g[c0], g1 = p.ln_v_g[c0 + 1], b0 = p.ln_v_b[c0], b1 = p.ln_v_b[c0 + 1];
      unsigned n0[16], n1[16];
#pragma unroll
      for (int i2 = 0; i2 < 16; ++i2) { float a[2], b[2];
#pragma unroll
          for (int u = 0; u < 2; ++u) { const int s = 32 * hw + 2 * i2 + u; const unsigned vw = valid ? *(const unsigned*)(P + PJ_V * PSTRIDE + (size_t)(r0 + s) * DM + c0) : 0u;
              const float mu = *(const LAS float*)(hl + GST_OFF + s * 4), rs = *(const LAS float*)(hl + GST_OFF + 512 + s * 4);
              a[u] = (bflo(vw) - mu) * rs * g0 + b0; b[u] = (bfhi(vw) - mu) * rs * g1 + b1; }
          n0[i2] = pk2c(a[0], a[1]); n1[i2] = pk2c(b[0], b[1]); }
      LAS unsigned char* np = hl + VN_OFF + (2 * lane) * VN_STR + 64 * hw;
#pragma unroll
      for (int k = 0; k < 4; ++k) { *(LAS u32x4*)(np + 16 * k) = (u32x4){n0[4 * k], n0[4 * k + 1], n0[4 * k + 2], n0[4 * k + 3]}; *(LAS u32x4*)(np + VN_STR + 16 * k) = (u32x4){n1[4 * k], n1[4 * k + 1], n1[4 * k + 2], n1[4 * k + 3]}; } }
    __syncthreads();
    f32x16 acc[4];
#pragma unroll
    for (int m = 0; m < 4; ++m)
#pragma unroll
        for (int i = 0; i < 16; ++i) acc[m][i] = 0.f;
    const bf16_t* wrow = (const bf16_t*)(p.ws + WS_WSB) + ((size_t)h * 128 + 32 * hw + r) * 128 + 8 * h_;
#pragma unroll
    for (int ks = 0; ks < 8; ++ks) { const bf16x8 wf = *(const bf16x8*)(wrow + 16 * ks);
#pragma unroll
        for (int m = 0; m < 4; ++m) { const bf16x8 af = *(const LAS bf16x8*)(hl + VN_OFF + (32 * m + r) * VN_STR + ks * 32 + 16 * h_); acc[m] = MFMA32(af, wf, acc[m]); } }
    const int t = 32 * hw + r, tok = r0 + t; const float bs = p.b_s[h * 128 + t];
    if (valid) {
#pragma unroll
        for (int m = 0; m < 4; ++m)
#pragma unroll
            for (int g = 0; g < 4; ++g) { const size_t o = (size_t)tok * DM + h * 128 + 32 * m + 8 * g + 4 * h_;
                const u32x2 uw = *(const u32x2*)(P + PJ_U * PSTRIDE + o), zw = *(const u32x2*)(P + PJ_ZA * PSTRIDE + o);
                const float y0 = bflo(uw.x) * (acc[m][4 * g] + bs) * bflo(zw.x), y1 = bfhi(uw.x) * (acc[m][4 * g + 1] + bs) * bfhi(zw.x), y2 = bflo(uw.y) * (acc[m][4 * g + 2] + bs) * bflo(zw.y), y3 = bfhi(uw.y) * (acc[m][4 * g + 3] + bs) * bfhi(zw.y);
                *(u32x2*)((bf16_t*)(p.ws + WS_MIX) + (size_t)tok * DMIX + h * 128 + 32 * m + 8 * g + 4 * h_) = (u32x2){pk2c(y0, y1), pk2c(y2, y3)}; }
    }
    __syncthreads();
}
__device__ __forceinline__ void phase_gmlp_scan1(const Params& p, int g, LAS unsigned char* lds) {
    const int tid = opaque_tid(), lane = tid & 63, wave = __builtin_amdgcn_readfirstlane(tid >> 6), half = wave >> 2, hw = wave & 3;
    LAS unsigned char* hl = lds + half * HALF_LDS;
    const int hb = blockIdx.x * 2 + half, NHB = gridDim.x * 2;
    constexpr int NG = (MG / 128) * NH, NS1 = NSC * NH * 2;
    for (int i = 0; i < (NG + NHB - 1) / NHB; ++i) { const int item = hb + i * NHB; gmlp_item(p, hl, item < NG ? item : 0, hw, lane, item < NG); }
    for (int i = 0; i < (NS1 + NHB - 1) / NHB; ++i) { const int item = hb + i * NHB; const bool valid = item < NS1; const int it = valid ? item : 0;
        scan_sweep<0>(p, hl, it >> 4, (it >> 1) & 7, it & 1, hw, lane, valid); }
}
__device__ __forceinline__ void phase_scan2(const Params& p, int g) {
    const int tid = opaque_tid();
    const int nseq = g < 2 ? 2 : 1, nsc = NSC / nseq;
    float* state = (float*)(p.ws + WS_STATE); const float* dec = (const float*)(p.ws + WS_DEC);
    for (int idx = blockIdx.x * blockDim.x + tid; idx < nseq * NH * 2 * 4096; idx += gridDim.x * blockDim.x) {
        const int e4 = idx & 4095, dir = (idx >> 12) & 1, h = (idx >> 13) & 7, seq = idx >> 16, c = e4 >> 5;
        f32x4 carry = {0.f, 0.f, 0.f, 0.f};
#pragma unroll 4
        for (int n = 0; n < nsc; ++n) { const int scn = seq * nsc + (dir ? nsc - 1 - n : n); const size_t sb = (size_t)(scn * NH + h) * 2 + dir;
            f32x4* sp = (f32x4*)(state + sb * STATE_SZ) + e4; const f32x4 tmp = *sp; *sp = carry; const float d = dec[sb * 128 + c]; carry = carry * d + tmp; }
    }
}
__device__ __forceinline__ void phase_scan3(const Params& p, int g, LAS unsigned char* lds) {
    const int tid = opaque_tid(), lane = tid & 63, wave = __builtin_amdgcn_readfirstlane(tid >> 6), half = wave >> 2, hw = wave & 3;
    LAS unsigned char* hl = lds + half * HALF_LDS;
    const int hb = blockIdx.x * 2 + half, NHB = gridDim.x * 2;
    constexpr int NS3 = NSC * NH;
    for (int i = 0; i < (NS3 + NHB - 1) / NHB; ++i) { const int item = hb + i * NHB; const bool valid = item < NS3; const int it = valid ? item : 0;
        scan_sweep<1>(p, hl, it >> 3, it & 7, 0, hw, lane, valid);
        asm volatile("s_waitcnt vmcnt(0)" ::: "memory"); __syncthreads();
        __builtin_amdgcn_fence(__ATOMIC_ACQUIRE, "agent"); asm volatile("s_waitcnt vmcnt(0)" ::: "memory"); __syncthreads();
        scan_sweep<2>(p, hl, it >> 3, it & 7, 1, hw, lane, valid);
    }
}

namespace cg = cooperative_groups;
__global__ void __launch_bounds__(512, 2) k_mega(Params p) {
    cg::grid_group grid = cg::this_grid();
    LAS unsigned char* lds = (LAS unsigned char*)lds_raw;
    phase_prologue(p, lds);
    grid.sync();
    for (int g = 0; g < NGROUPS; ++g) {
        phase_gemm_in(p, g, lds);
        grid.sync();
        phase_gmlp_scan1(p, g, lds);
        grid.sync();
        phase_scan2(p, g);
        grid.sync();
        phase_scan3(p, g, lds);
        grid.sync();
        phase_gemm_out(p, g, lds);
        grid.sync();
        phase_final(p, g);
    }
}

extern "C" void kernel_launch(void* const* d_in, const int* in_sizes, int n_in, void* d_out, int out_size, void* d_ws, size_t ws_size, hipStream_t stream) {
    static int grid = 0;
    if (grid == 0) {
        if (n_in != 12 || out_size != T_ALL * DM || ws_size < WS_END) { fprintf(stderr, "kernel_launch: unexpected shapes (n_in %d out %d ws %zu)\n", n_in, out_size, ws_size); grid = -1; return; }
        int dev = 0, cus = 0, per_cu = 0;
        if (hipGetDevice(&dev) != hipSuccess || hipDeviceGetAttribute(&cus, hipDeviceAttributeMultiprocessorCount, dev) != hipSuccess) { grid = -1; return; }
        if (hipFuncSetAttribute((const void*)k_mega, hipFuncAttributeMaxDynamicSharedMemorySize, LDS_BYTES) != hipSuccess) { fprintf(stderr, "kernel_launch: hipFuncSetAttribute failed\n"); grid = -1; return; }
        if (hipOccupancyMaxActiveBlocksPerMultiprocessor(&per_cu, (const void*)k_mega, 512, LDS_BYTES) != hipSuccess || per_cu < 1) { fprintf(stderr, "kernel_launch: occupancy query failed (%d)\n", per_cu); grid = -1; return; }
        grid = cus;
    }
    if (grid < 0) return;
    Params p{};
    p.x_prompt = (const float*)d_in[0]; p.x_sample = (const float*)d_in[1]; p.norm_g = (const float*)d_in[2]; p.w_in = (const float*)d_in[3];
    p.ln_v_g = (const float*)d_in[4]; p.ln_v_b = (const float*)d_in[5]; p.w_s = (const float*)d_in[6]; p.b_s = (const float*)d_in[7];
    p.lb_params = (const float*)d_in[8]; p.gn_g = (const float*)d_in[9]; p.w_out = (const float*)d_in[10]; p.final_g = (const float*)d_in[11];
    p.out = (float*)d_out; p.ws = (unsigned char*)d_ws;
    void* args[] = {&p};
    hipError_t e = hipLaunchCooperativeKernel((const void*)k_mega, dim3(grid), dim3(512), args, LDS_BYTES, stream);
    if (e != hipSuccess) fprintf(stderr, "kernel_launch: cooperative launch failed: %s (grid %d)\n", hipGetErrorString(e), grid);
}
```

```cpp
#include <hip/hip_runtime.h>
#include <hip/hip_cooperative_groups.h>
#include <cstdio>
#include <cstdint>
namespace pg8 {
#define PG8_LAS __attribute__((address_space(3)))
typedef unsigned short bf16_t;
typedef short bf16x8 __attribute__((ext_vector_type(8)));
typedef float f32x4 __attribute__((ext_vector_type(4)));
typedef unsigned u32x4 __attribute__((ext_vector_type(4)));
constexpr int BM = 256, BK = 64, HALF = 128, HTB = HALF * BK * 2  , STAGE_BYTES = 8 * HTB, NXCD = 8, WGM = 8;

__host__ __device__ __forceinline__ int lds_byte(int r, int c) { const int st = (r >> 4) * 2 + (c >> 5), rr = r & 15, cc = c & 31, ob = rr * 64 + cc * 2; return st * 1024 + (ob ^ (((ob >> 9) & 1) << 5)); }
__host__ __device__ __forceinline__ void stage_rc(int b, int& R, int& C) { const int st = b / 1024, sb = b % 1024, swz = sb ^ (((sb >> 9) & 1) << 5); R = (st >> 1) * 16 + swz / 64; C = (st & 1) * 32 + (swz % 64) / 2; }
__host__ __device__ __forceinline__ int perm32(int rho) { const int n = rho >> 4, i = rho & 15; return 8 * (i >> 2) + 4 * n + (i & 3); }

struct Unit { int pm, pn; };
struct Gemm { const bf16_t* A; const bf16_t* Bt; int M, N, K, lda; };

struct StaticOrder {
    int nM, nN, nwg, G, c;
    __host__ __device__ void init(int M, int N, int G_, int c_) { nM = M / BM; nN = N / BM; nwg = nM * nN; G = G_; c = c_; }
    __host__ __device__ bool next(int i, Unit& u) const {
        const long L = (long)i * G + c; if (L >= nwg) return false;
        int wgid = (int)L; { const int q = nwg / NXCD, r = nwg % NXCD, xcd = wgid % NXCD, off = wgid / NXCD; wgid = (xcd < r ? xcd * (q + 1) : r * (q + 1) + (xcd - r) * q) + off; }
        const int nig = WGM * nN, gid = wgid / nig, fm = gid * WGM, gsz = (nM - fm) < WGM ? (nM - fm) : WGM;
        u.pm = fm + ((wgid % nig) % gsz); u.pn = (wgid % nig) / gsz; return true;
    }
    __device__ __forceinline__ void a_ready(const Unit&) const {}
    __device__ __forceinline__ void done(const Unit&) const {}
};
__device__ __forceinline__ unsigned cvt_pk_bf16(float lo, float hi) { unsigned r; asm volatile("v_cvt_pk_bf16_f32 %0, %1, %2" : "=v"(r) : "v"(lo), "v"(hi)); return r; }
typedef float f32x2 __attribute__((ext_vector_type(2)));

template <class Epi, class Sched, bool ALIGN_EPI = false, bool SP2 = false>
__device__ __forceinline__ void gemm_phase(PG8_LAS unsigned char* lds, const Gemm g, const Sched& S, const Epi& E) {
    int tid_ = threadIdx.x; asm volatile("" : "+v"(tid_));
    const int tid = tid_, wid = __builtin_amdgcn_readfirstlane(tid >> 6), lane = tid & 63, wr = wid >> 2, wc = wid & 3, fr = lane & 15, fq = lane >> 4;
    const int K = g.K, nt = K / BK;
    unsigned voffA[2], voffB[2];
#pragma unroll
    for (int i = 0; i < 2; ++i) { int R, C; stage_rc(tid * 16 + i * 8192, R, C); const int Rb = Epi::PERM ? ((R & ~31) + perm32(R & 31)) : R;
        voffA[i] = (unsigned)(R * g.lda + C) * 2u; voffB[i] = (unsigned)(Rb * K + C) * 2u; }
    const size_t kstep = (size_t)(BK * 2);
    const size_t hstep = (size_t)HALF * K * 2, hstepA = (size_t)HALF * g.lda * 2;
    const size_t tstep = 2 * hstep, tstepA = 2 * hstepA;
    const unsigned ldsw = (unsigned)wid * 1024u;
    const int aoff = lds_byte(wr * 64 + fr, fq * 8), boff = lds_byte(wc * 32 + fr, fq * 8);
#define PG8_SA(b, h) (((b) * 2 + (h)) * HTB)
#define PG8_SB(b, h) ((4 + (b) * 2 + (h)) * HTB)
#define PG8_STAGE(bufoff, gbase, voff) do { _Pragma("unroll") for (int _i = 0; _i < 2; ++_i) \
        __builtin_amdgcn_global_load_lds((const unsigned*)((const char*)(gbase) + (voff)[_i]), (PG8_LAS unsigned*)(lds + (bufoff) + ldsw + _i * 8192), 16, 0, 0); } while (0)
#define PG8_LDA(dst, b, h) do { _Pragma("unroll") for (int m = 0; m < 4; ++m) _Pragma("unroll") for (int k = 0; k < 2; ++k) dst[m][k] = *(const PG8_LAS bf16x8*)(lds + PG8_SA(b, h) + aoff + m * 2048 + k * 1024); } while (0)
#define PG8_LDB(dst, b, h) do { _Pragma("unroll") for (int n = 0; n < 2; ++n) _Pragma("unroll") for (int k = 0; k < 2; ++k) dst[n][k] = *(const PG8_LAS bf16x8*)(lds + PG8_SB(b, h) + boff + n * 2048 + k * 1024); } while (0)
#define PG8_MMA(ai, bj, At, Bt) do { __builtin_amdgcn_s_setprio(1); _Pragma("unroll") for (int m = 0; m < 4; ++m) _Pragma("unroll") for (int n = 0; n < 2; ++n) _Pragma("unroll") for (int k = 0; k < 2; ++k) \
        acc[ai][bj][m][n] = __builtin_amdgcn_mfma_f32_16x16x32_bf16(Bt[n][k], At[m][k], acc[ai][bj][m][n], 0, 0, 0); __builtin_amdgcn_s_setprio(0); } while (0)
#define PG8_WAIT_V(n) asm volatile("s_waitcnt vmcnt(" #n ")" ::: "memory")
#define PG8_WAIT_L(n) asm volatile("s_waitcnt lgkmcnt(" #n ")" ::: "memory")
#define PG8_BAR __builtin_amdgcn_s_barrier()
#define PG8_SCHED __builtin_amdgcn_sched_barrier(0)
    Unit cur, nxt; int ui = 0;
    if (!S.next(0, cur)) return;
    f32x4 acc[2][2][4][2];
#pragma unroll
    for (int a = 0; a < 2; ++a)
#pragma unroll
        for (int b = 0; b < 2; ++b)
#pragma unroll
            for (int m = 0; m < 4; ++m)
#pragma unroll
                for (int n = 0; n < 2; ++n) acc[a][b][m][n] = (f32x4){0.f, 0.f, 0.f, 0.f};
    bf16x8 At[4][2], B0[2][2], B1[2][2];
    const char* cA = (const char*)g.A + (size_t)cur.pm * tstepA; const char* cB = (const char*)g.Bt + (size_t)cur.pn * tstep;
    S.a_ready(cur);
    if constexpr (SP2) {
        PG8_STAGE(PG8_SB(0, 0), cB, voffB); PG8_STAGE(PG8_SB(0, 1), cB + hstep, voffB); PG8_STAGE(PG8_SA(0, 0), cA, voffA); PG8_STAGE(PG8_SA(0, 1), cA + hstepA, voffA);
        if (wr == 1) PG8_BAR;
        PG8_WAIT_V(2); PG8_BAR;
        PG8_STAGE(PG8_SB(1, 0), cB + kstep, voffB); PG8_STAGE(PG8_SA(1, 0), cA + kstep, voffA); PG8_STAGE(PG8_SB(1, 1), cB + hstep + kstep, voffB);
        PG8_WAIT_V(6); PG8_BAR;
    } else {
        PG8_STAGE(PG8_SB(0, 0), cB, voffB); PG8_STAGE(PG8_SA(0, 0), cA, voffA); PG8_STAGE(PG8_SB(0, 1), cB + hstep, voffB); PG8_STAGE(PG8_SA(0, 1), cA + hstepA, voffA);
        if (wr == 1) PG8_BAR;
        PG8_WAIT_V(4); PG8_BAR;
        PG8_STAGE(PG8_SB(1, 0), cB + kstep, voffB); PG8_STAGE(PG8_SA(1, 0), cA + kstep, voffA); PG8_STAGE(PG8_SB(1, 1), cB + hstep + kstep, voffB);
        PG8_WAIT_V(6); PG8_BAR;
    }
    for (;;) {
        const bool has_next = S.next(ui + 1, nxt);
        const char* nA = has_next ? (const char*)g.A + (size_t)nxt.pm * tstepA : cA; const char* nB = has_next ? (const char*)g.Bt + (size_t)nxt.pn * tstep : cB;
        for (int t = 0; t < nt; t += 2) {
            const bool last = (t == nt - 2);
            const char* a1 = cA + (size_t)(t + 1) * kstep;
            const char* a2 = last ? nA : cA + (size_t)(t + 2) * kstep; const char* b2 = last ? nB : cB + (size_t)(t + 2) * kstep;
            const char* a3 = a2 + kstep; const char* b3 = b2 + kstep;
            if (last && has_next) S.a_ready(nxt);
            if constexpr (SP2) {
            PG8_LDB(B0, 0, 0); PG8_LDB(B1, 0, 1); PG8_SCHED; PG8_LDA(At, 0, 0); PG8_STAGE(PG8_SA(1, 1), a1 + hstepA, voffA);
            PG8_WAIT_V(8); PG8_WAIT_L(0); PG8_BAR; PG8_MMA(0, 0, At, B0); PG8_MMA(0, 1, At, B1); PG8_BAR; PG8_SCHED;
            PG8_LDA(At, 0, 1); PG8_STAGE(PG8_SB(0, 0), b2, voffB); PG8_STAGE(PG8_SB(0, 1), b2 + hstep, voffB); PG8_STAGE(PG8_SA(0, 0), a2, voffA);
            PG8_WAIT_V(8); PG8_WAIT_L(0); PG8_BAR; PG8_MMA(1, 0, At, B0); PG8_MMA(1, 1, At, B1); PG8_BAR; PG8_SCHED;
            PG8_LDB(B0, 1, 0); PG8_LDB(B1, 1, 1); PG8_SCHED; PG8_LDA(At, 1, 0); PG8_STAGE(PG8_SA(0, 1), a2 + hstepA, voffA);
            PG8_WAIT_V(8); PG8_WAIT_L(0); PG8_BAR; PG8_MMA(0, 0, At, B0); PG8_MMA(0, 1, At, B1); PG8_BAR; PG8_SCHED;
            PG8_LDA(At, 1, 1); PG8_STAGE(PG8_SB(1, 0), b3, voffB); PG8_STAGE(PG8_SB(1, 1), b3 + hstep, voffB); PG8_STAGE(PG8_SA(1, 0), a3, voffA);
            PG8_WAIT_V(8); PG8_WAIT_L(0); PG8_BAR; PG8_MMA(1, 0, At, B0); PG8_MMA(1, 1, At, B1); PG8_BAR; PG8_SCHED;
            } else {
            PG8_LDB(B0, 0, 0); PG8_SCHED; PG8_LDA(At, 0, 0); PG8_STAGE(PG8_SA(1, 1), a1 + hstepA, voffA);
            PG8_WAIT_L(8); PG8_BAR; PG8_WAIT_L(0); PG8_MMA(0, 0, At, B0); PG8_BAR; PG8_SCHED;
            PG8_LDB(B1, 0, 1); PG8_STAGE(PG8_SB(0, 0), b2, voffB);
            PG8_BAR; PG8_WAIT_L(0); PG8_MMA(0, 1, At, B1); PG8_BAR;
            PG8_LDA(At, 0, 1); PG8_STAGE(PG8_SA(0, 0), a2, voffA);
            PG8_BAR; PG8_WAIT_L(0); PG8_MMA(1, 0, At, B0); PG8_BAR; PG8_SCHED;
            PG8_STAGE(PG8_SB(0, 1), b2 + hstep, voffB);
            PG8_WAIT_V(6); PG8_BAR; PG8_MMA(1, 1, At, B1); PG8_BAR;
            PG8_LDB(B0, 1, 0); PG8_SCHED; PG8_LDA(At, 1, 0); PG8_STAGE(PG8_SA(0, 1), a2 + hstepA, voffA);
            PG8_WAIT_L(8); PG8_BAR; PG8_WAIT_L(0); PG8_MMA(0, 0, At, B0); PG8_BAR; PG8_SCHED;
            PG8_LDB(B1, 1, 1); PG8_STAGE(PG8_SB(1, 0), b3, voffB);
            PG8_BAR; PG8_WAIT_L(0); PG8_MMA(0, 1, At, B1); PG8_BAR;
            PG8_LDA(At, 1, 1); PG8_STAGE(PG8_SA(1, 0), a3, voffA);
            PG8_BAR; PG8_WAIT_L(0); PG8_MMA(1, 0, At, B0); PG8_BAR; PG8_SCHED;
            PG8_STAGE(PG8_SB(1, 1), b3 + hstep, voffB);
            PG8_WAIT_V(6); PG8_BAR; PG8_MMA(1, 1, At, B1); PG8_BAR;
            }
        }
        if constexpr (ALIGN_EPI) { if (wr == 0) PG8_BAR; }
        if constexpr (!Epi::AFTER_DRAIN) { E(acc, cur, wr, wc, fr, fq); S.done(cur); }
        if (!has_next) break;
#pragma unroll
        for (int a = 0; a < 2; ++a)
#pragma unroll
            for (int b = 0; b < 2; ++b)
#pragma unroll
                for (int m = 0; m < 4; ++m)
#pragma unroll
                    for (int n = 0; n < 2; ++n) acc[a][b][m][n] = (f32x4){0.f, 0.f, 0.f, 0.f};
        cur = nxt; cA = nA; cB = nB; ++ui;
        if constexpr (ALIGN_EPI) { if (wr == 1) PG8_BAR; }
    }
    PG8_WAIT_V(0);
    if constexpr (!ALIGN_EPI) { if (wr == 0) PG8_BAR; }
    PG8_BAR;
    if constexpr (Epi::AFTER_DRAIN) { E.fused(acc, cur, wr, wc, fr, fq, lds, wid, lane); S.done(cur); }
#undef PG8_SA
#undef PG8_SB
#undef PG8_STAGE
#undef PG8_LDA
#undef PG8_LDB
#undef PG8_MMA
#undef PG8_WAIT_V
#undef PG8_WAIT_L
#undef PG8_BAR
#undef PG8_SCHED
}
}
using pg8::bf16_t; using pg8::f32x4; using pg8::u32x4; using pg8::bf16x8;
#define LAS __attribute__((address_space(3)))
typedef unsigned u32x2 __attribute__((ext_vector_type(2)));
typedef float f32x2v __attribute__((ext_vector_type(2)));
constexpr int DM = 1024, DIN = 8192, DMIX = 2048, T_ALL = 49152, MG = 16384, NGROUPS = 3, NH = 8, HD = 128;
constexpr float EPS = 1e-6f;
constexpr size_t MiB = 1u << 20;
constexpr size_t WS_CTL = 0, WS_OML = 1 * MiB, WS_WSB = 1 * MiB + 65536, WS_RS = 1 * MiB + 524288;
constexpr size_t WS_WIT = 2 * MiB, WS_WOT = 18 * MiB, WS_VSTAT = 22 * MiB, WS_OSTAT = 24 * MiB, WS_STATE = 26 * MiB, WS_DEC = 90 * MiB;
constexpr size_t WS_P = 92 * MiB, WS_MIX = 348 * MiB, WS_OF = 412 * MiB, WS_END = 476 * MiB;
constexpr size_t PSTRIDE = (size_t)MG * DM;
enum { PJ_U = 0, PJ_V = 1, PJ_ZA = 2, PJ_Q = 3, PJ_KF = 4, PJ_KB = 5, PJ_I = 6, PJ_ZB = 7 };

__device__ __forceinline__ unsigned f2bf(float f) { unsigned u = __float_as_uint(f); return (u + 0x7fffu + ((u >> 16) & 1u)) >> 16; }
__device__ __forceinline__ float bf2f(unsigned b) { return __uint_as_float(b << 16); }
__device__ __forceinline__ float bflo(unsigned w) { return __uint_as_float(w << 16); }
__device__ __forceinline__ float bfhi(unsigned w) { return __uint_as_float(w & 0xffff0000u); }
__device__ __forceinline__ unsigned pk2(float lo, float hi) { return pg8::cvt_pk_bf16(lo, hi); }
__device__ __forceinline__ float wave_sum(float v) {
#pragma unroll
    for (int o = 1; o < 64; o <<= 1) v += __shfl_xor(v, o);
    return v;
}
__device__ __forceinline__ int opaque_tid() { int t = threadIdx.x; asm volatile("" : "+v"(t)); return t; }
__device__ __forceinline__ float fast_rcp(float x) { return __builtin_amdgcn_rcpf(x); }
__device__ __forceinline__ float silu_f(float z) { return z * fast_rcp(1.0f + __expf(-z)); }

struct Params {
    const float* x_prompt; const float* x_sample; const float* norm_g; const float* w_in; const float* ln_v_g; const float* ln_v_b;
    const float* w_s; const float* b_s; const float* lb_params; const float* gn_g; const float* w_out; const float* final_g;
    float* out; unsigned char* ws;
};
__device__ __forceinline__ const float* x_row(const Params& p, int tok) { return tok < 32768 ? p.x_prompt + (size_t)tok * DM : p.x_sample + (size_t)(tok - 32768) * DM; }
__device__ __forceinline__ bf16_t* xb_row(const Params& p, int tok) { return (bf16_t*)((unsigned char*)p.out + (size_t)tok * 4096 + 2048); }

namespace pg8 {
struct EpiIn {
    static constexpr bool PERM = true, AFTER_DRAIN = false;
    bf16_t* P; const float* rs; const float* oml; float* vstat;
    __device__ __forceinline__ void operator()(const f32x4 (&acc)[2][2][4][2], const Unit& u, int wr, int wc, int fr, int fq) const {
        const int grp = u.pn >> 2;
        const int row0 = u.pm * BM + wr * 64 + fr;
        const int colt = (u.pn & 3) * BM + wc * 32 + 8 * fq;
        bf16_t* base = P + (size_t)grp * PSTRIDE + colt;
        float rsv[2][4];
#pragma unroll
        for (int ai = 0; ai < 2; ++ai)
#pragma unroll
            for (int m = 0; m < 4; ++m) rsv[ai][m] = rs[row0 + ai * HALF + m * 16];
        if (grp == PJ_KF || grp == PJ_KB) {
            const float* om = oml + (grp - PJ_KF) * DM + colt;
            f32x4 o[2][2];
#pragma unroll
            for (int bj = 0; bj < 2; ++bj)
#pragma unroll
                for (int n = 0; n < 2; ++n) o[bj][n] = *(const f32x4*)(om + bj * HALF + 4 * n);
#pragma unroll
            for (int ai = 0; ai < 2; ++ai)
#pragma unroll
                for (int m = 0; m < 4; ++m) { bf16_t* rowp = base + (size_t)(row0 + ai * HALF + m * 16) * DM;
#pragma unroll
                    for (int bj = 0; bj < 2; ++bj) { f32x4 v0 = acc[ai][bj][m][0] * rsv[ai][m], v1 = acc[ai][bj][m][1] * rsv[ai][m];
#pragma unroll
                        for (int j = 0; j < 4; ++j) { v0[j] = o[bj][0][j] * fast_rcp(1.0f + __expf(v0[j])); v1[j] = o[bj][1][j] * fast_rcp(1.0f + __expf(v1[j])); }
                        u32x4 w; w.x = cvt_pk_bf16(v0[0], v0[1]); w.y = cvt_pk_bf16(v0[2], v0[3]); w.z = cvt_pk_bf16(v1[0], v1[1]); w.w = cvt_pk_bf16(v1[2], v1[3]);
                        *(u32x4*)(rowp + bj * HALF) = w; } }
        } else if (grp == PJ_ZA || grp == PJ_Q || grp == PJ_ZB) {
#pragma unroll
            for (int ai = 0; ai < 2; ++ai)
#pragma unroll
                for (int m = 0; m < 4; ++m) { bf16_t* rowp = base + (size_t)(row0 + ai * HALF + m * 16) * DM;
#pragma unroll
                    for (int bj = 0; bj < 2; ++bj) { f32x4 v0 = acc[ai][bj][m][0] * rsv[ai][m], v1 = acc[ai][bj][m][1] * rsv[ai][m];
#pragma unroll
                        for (int j = 0; j < 4; ++j) { v0[j] = silu_f(v0[j]); v1[j] = silu_f(v1[j]); }
                        u32x4 w; w.x = cvt_pk_bf16(v0[0], v0[1]); w.y = cvt_pk_bf16(v0[2], v0[3]); w.z = cvt_pk_bf16(v1[0], v1[1]); w.w = cvt_pk_bf16(v1[2], v1[3]);
                        *(u32x4*)(rowp + bj * HALF) = w; } }
        } else {
#pragma unroll
            for (int ai = 0; ai < 2; ++ai)
#pragma unroll
                for (int m = 0; m < 4; ++m) { const int row = row0 + ai * HALF + m * 16; bf16_t* rowp = base + (size_t)row * DM; float s = 0.f, q = 0.f;
#pragma unroll
                    for (int bj = 0; bj < 2; ++bj) { const f32x4 v0 = acc[ai][bj][m][0] * rsv[ai][m], v1 = acc[ai][bj][m][1] * rsv[ai][m];
                        s += ((v0[0] + v0[1]) + (v0[2] + v0[3])) + ((v1[0] + v1[1]) + (v1[2] + v1[3]));
                        q += ((v0[0] * v0[0] + v0[1] * v0[1]) + (v0[2] * v0[2] + v0[3] * v0[3])) + ((v1[0] * v1[0] + v1[1] * v1[1]) + (v1[2] * v1[2] + v1[3] * v1[3]));
                        u32x4 w; w.x = cvt_pk_bf16(v0[0], v0[1]); w.y = cvt_pk_bf16(v0[2], v0[3]); w.z = cvt_pk_bf16(v1[0], v1[1]); w.w = cvt_pk_bf16(v1[2], v1[3]);
                        *(u32x4*)(rowp + bj * HALF) = w; }
                    if (grp == PJ_V) { s += __shfl_xor(s, 16); s += __shfl_xor(s, 32); q += __shfl_xor(q, 16); q += __shfl_xor(q, 32);
                        if (fq == 0) *(f32x2v*)(vstat + (size_t)row * 32 + ((u.pn & 3) * 4 + wc) * 2) = (f32x2v){s, q}; } }
        }
    }
};
struct EpiOut {
    static constexpr bool PERM = false, AFTER_DRAIN = false;
    const float* xg; float* out; float* ostat;
    __device__ __forceinline__ void operator()(const f32x4 (&acc)[2][2][4][2], const Unit& u, int wr, int wc, int fr, int fq) const {
        const int row0 = u.pm * BM + wr * 64 + fr, col0 = u.pn * BM + wc * 32 + 4 * fq;
#pragma unroll
        for (int ai = 0; ai < 2; ++ai)
#pragma unroll
            for (int m = 0; m < 4; ++m) { const int row = row0 + ai * HALF + m * 16; const size_t off = (size_t)row * DM + col0; float q = 0.f;
#pragma unroll
                for (int bj = 0; bj < 2; ++bj)
#pragma unroll
                    for (int n = 0; n < 2; ++n) { const f32x4 r = *(const f32x4*)(xg + off + bj * HALF + n * 16) + acc[ai][bj][m][n];
                        q += (r[0] * r[0] + r[1] * r[1]) + (r[2] * r[2] + r[3] * r[3]); *(f32x4*)(out + off + bj * HALF + n * 16) = r; }
                q += __shfl_xor(q, 16); q += __shfl_xor(q, 32);
                if (fq == 0) ostat[(size_t)row * 16 + u.pn * 4 + wc] = q; }
    }
};
}
constexpr int LDS_BYTES = 147456;
extern __shared__ __attribute__((aligned(16))) unsigned char lds_raw[];

__device__ __forceinline__ void transpose_item(const float* W, int K, int N, const float* gk, bf16_t* WT, LAS float* scr, int item, int lane) {
    const int nblk = N / 32, kb = item / nblk, nb = item % nblk, k0 = 64 * kb, n0 = 32 * nb;
#pragma unroll 8
    for (int i = 0; i < 32; ++i) { const int kk = 2 * i + (lane >> 5); float w = W[(size_t)(k0 + kk) * N + n0 + (lane & 31)]; if (gk) w *= gk[k0 + kk]; scr[kk * 33 + (lane & 31)] = w; }
    asm volatile("s_waitcnt lgkmcnt(0)" ::: "memory");
    const int c = lane & 7;
#pragma unroll
    for (int j = 0; j < 4; ++j) { const int n = (lane >> 3) + 8 * j; const LAS float* s = scr + (8 * c) * 33 + n;
        u32x4 o; o.x = pk2(s[0 * 33], s[1 * 33]); o.y = pk2(s[2 * 33], s[3 * 33]); o.z = pk2(s[4 * 33], s[5 * 33]); o.w = pk2(s[6 * 33], s[7 * 33]);
        *(u32x4*)(WT + (size_t)(n0 + n) * K + k0 + 8 * c) = o; }
    asm volatile("s_waitcnt lgkmcnt(0)" ::: "memory");
}
__device__ __forceinline__ void phase_prologue(const Params& p, LAS unsigned char* lds) {
    const int tid = opaque_tid(), lane = tid & 63, wave = tid >> 6, nw = blockDim.x >> 6;
    const int gw = blockIdx.x * nw + wave, NGW = gridDim.x * nw;
    LAS float* scr = (LAS float*)(lds + wave * 16384);
    bf16_t* wit = (bf16_t*)(p.ws + WS_WIT); bf16_t* wot = (bf16_t*)(p.ws + WS_WOT);
    constexpr int I_IN = (DM / 64) * (DIN / 32), I_OUT = (DMIX / 64) * (DM / 32);
    for (int it = gw; it < I_IN + I_OUT; it += NGW) {
        if (it < I_IN) transpose_item(p.w_in, DM, DIN, p.norm_g, wit, scr, it, lane);
        else transpose_item(p.w_out, DMIX, DM, nullptr, wot, scr, it - I_IN, lane);
    }
    const int gt = blockIdx.x * blockDim.x + tid, NGT = gridDim.x * blockDim.x;
    bf16_t* wsb = (bf16_t*)(p.ws + WS_WSB);
    for (int i = gt; i < NH * 128 * 128; i += NGT) wsb[i] = (bf16_t)f2bf(p.w_s[i]);
    float* oml = (float*)(p.ws + WS_OML);
    for (int i = gt; i < 2 * DM; i += NGT) { const int d = i / DM, c = i % DM; const float a = p.lb_params[(d * 2 + 0) * DM + c], b = p.lb_params[(d * 2 + 1) * DM + c];
        const float mx = fmaxf(a, b), ea = expf(a - mx), eb = expf(b - mx); oml[i] = eb / (ea + eb); }
    float* rs = (float*)(p.ws + WS_RS);
    for (int tok = gw; tok < T_ALL; tok += NGW) {
        const f32x4* xr = (const f32x4*)x_row(p, tok) + lane; f32x4 v[4]; float s = 0.f;
#pragma unroll
        for (int j = 0; j < 4; ++j) { v[j] = xr[64 * j]; s += (v[j][0] * v[j][0] + v[j][1] * v[j][1]) + (v[j][2] * v[j][2] + v[j][3] * v[j][3]); }
        s = wave_sum(s);
        if (lane == 0) rs[tok] = 1.0f / sqrtf(s * (1.0f / DM) + EPS);
        u32x2* o = (u32x2*)xb_row(p, tok) + lane;
#pragma unroll
        for (int j = 0; j < 4; ++j) o[64 * j] = (u32x2){pk2(v[j][0], v[j][1]), pk2(v[j][2], v[j][3])};
    }
}

__device__ __forceinline__ void phase_gemm_in(const Params& p, int g, LAS unsigned char* lds) {
    pg8::Gemm gm{xb_row(p, g * MG), (const bf16_t*)(p.ws + WS_WIT), MG, DIN, DM, 2 * DM};
    pg8::StaticOrder S; S.init(MG, DIN, gridDim.x, blockIdx.x);
    pg8::EpiIn E{(bf16_t*)(p.ws + WS_P), (const float*)(p.ws + WS_RS) + g * MG, (const float*)(p.ws + WS_OML), (float*)(p.ws + WS_VSTAT)};
    pg8::gemm_phase<pg8::EpiIn, pg8::StaticOrder, true, true>(lds, gm, S, E);
}
__device__ __forceinline__ void phase_gemm_out(const Params& p, int g, LAS unsigned char* lds) {
    pg8::Gemm gm{(const bf16_t*)(p.ws + WS_MIX), (const bf16_t*)(p.ws + WS_WOT), MG, DM, DMIX, DMIX};
    pg8::StaticOrder S; S.init(MG, DM, gridDim.x, blockIdx.x);
    pg8::EpiOut E{x_row(p, g * MG), p.out + (size_t)g * MG * DM, (float*)(p.ws + WS_OSTAT)};
    pg8::gemm_phase<pg8::EpiOut, pg8::StaticOrder, true, true>(lds, gm, S, E);
}
__device__ __forceinline__ void phase_final(const Params& p, int g) {
    const int tid = opaque_tid(), lane = tid & 63, wave = tid >> 6, nw = blockDim.x >> 6;
    const float* ostat = (const float*)(p.ws + WS_OSTAT);
    for (int row = blockIdx.x * nw + wave; row < MG; row += gridDim.x * nw) {
        float q = lane < 16 ? ostat[(size_t)row * 16 + lane] : 0.f; q = wave_sum(q);
        const float r = 1.0f / sqrtf(q * (1.0f / DM) + EPS);
        f32x4* o = (f32x4*)(p.out + ((size_t)g * MG + row) * DM) + lane; const f32x4* fg = (const f32x4*)p.final_g + lane;
#pragma unroll
        for (int j = 0; j < 4; ++j) o[64 * j] = o[64 * j] * r * fg[64 * j];
    }
}

__device__ __forceinline__ void phase_gmlp_simple(const Params& p, int g, LAS unsigned char* lds) {
    LAS float* vn = (LAS float*)lds; LAS float* mu = vn + 128 * 128; LAS float* rstd = mu + 128;
    const int tid = opaque_tid();
    const bf16_t* P = (const bf16_t*)(p.ws + WS_P); const float* vstat = (const float*)(p.ws + WS_VSTAT);
    bf16_t* mix = (bf16_t*)(p.ws + WS_MIX);
    for (int item = blockIdx.x; item < (MG / 128) * NH; item += gridDim.x) {
        const int chunk = item >> 3, h = item & 7, r0 = chunk * 128;
        __syncthreads();
        if (tid < 128) { float s = 0.f, q = 0.f; for (int i = 0; i < 16; ++i) { s += vstat[(size_t)(r0 + tid) * 32 + 2 * i]; q += vstat[(size_t)(r0 + tid) * 32 + 2 * i + 1]; }
            const float m = s * (1.0f / DM), var = q * (1.0f / DM) - m * m; mu[tid] = m; rstd[tid] = 1.0f / sqrtf(var + EPS); }
        __syncthreads();
        for (int idx = tid; idx < 128 * 128; idx += 512) { const int s = idx >> 7, c = idx & 127; const float v = bf2f(P[PJ_V * PSTRIDE + (size_t)(r0 + s) * DM + h * 128 + c]);
            vn[idx] = (v - mu[s]) * rstd[s] * p.ln_v_g[h * 128 + c] + p.ln_v_b[h * 128 + c]; }
        __syncthreads();
        const int c = tid & 127, t0 = (tid >> 7) * 32;
        for (int t = t0; t < t0 + 32; ++t) {
            const float* w = p.w_s + ((size_t)h * 128 + t) * 128; float acc = 0.f;
#pragma unroll 8
            for (int s = 0; s < 128; ++s) acc += w[s] * vn[s * 128 + c];
            acc += p.b_s[h * 128 + t];
            const size_t o = (size_t)(r0 + t) * DM + h * 128 + c;
            const float val = bf2f(P[PJ_U * PSTRIDE + o]) * acc * bf2f(P[PJ_ZA * PSTRIDE + o]);
            mix[(size_t)(r0 + t) * DMIX + h * 128 + c] = (bf16_t)f2bf(val);
        }
    }
}
__device__ __forceinline__ void phase_scan_simple(const Params& p, int g) {
    const int tid = opaque_tid(), lane = tid & 63, wave = tid >> 6;
    const int nseq = g < 2 ? 2 : 1, L = MG / nseq;
    const bf16_t* P = (const bf16_t*)(p.ws + WS_P);
    for (int item = wave * gridDim.x + blockIdx.x; item < nseq * 256; item += gridDim.x * (blockDim.x >> 6)) {
        const int vs = item & 15, dir = (item >> 4) & 1, h = (item >> 5) & 7, seq = item >> 8;
        float* O = (float*)(p.ws + (dir ? WS_STATE : WS_OF));
        float S0[8], S1[8];
#pragma unroll
        for (int j = 0; j < 8; ++j) { S0[j] = 0.f; S1[j] = 0.f; }
#pragma unroll 4
        for (int step = 0; step < L; ++step) {
            const int row = seq * L + (dir ? L - 1 - step : step);
            const size_t o = (size_t)row * DM + h * 128;
            const unsigned kw = *(const unsigned*)(P + (PJ_KF + dir) * PSTRIDE + o + 2 * lane);
            const unsigned qw = *(const unsigned*)(P + PJ_Q * PSTRIDE + o + 2 * lane);
            const u32x4 vw = *(const u32x4*)(P + PJ_I * PSTRIDE + o + vs * 8);
            const float k0 = bflo(kw), k1 = bfhi(kw), f0 = 1.0f - k0, f1 = 1.0f - k1, q0 = bflo(qw), q1 = bfhi(qw);
            float v[8] = {bflo(vw.x), bfhi(vw.x), bflo(vw.y), bfhi(vw.y), bflo(vw.z), bfhi(vw.z), bflo(vw.w), bfhi(vw.w)}, pr[8];
#pragma unroll
            for (int j = 0; j < 8; ++j) { S0[j] = f0 * S0[j] + k0 * v[j]; S1[j] = f1 * S1[j] + k1 * v[j]; pr[j] = S0[j] * q0 + S1[j] * q1; }
            float a4[4], a2[2], a1;
            { const bool hi = lane & 32;
#pragma unroll
              for (int i = 0; i < 4; ++i) { const float send = hi ? pr[i] : pr[4 + i]; const float keep = hi ? pr[4 + i] : pr[i]; a4[i] = keep + __shfl_xor(send, 32); } }
            { const bool hi = lane & 16;
#pragma unroll
              for (int i = 0; i < 2; ++i) { const float send = hi ? a4[i] : a4[2 + i]; const float keep = hi ? a4[2 + i] : a4[i]; a2[i] = keep + __shfl_xor(send, 16); } }
            { const bool hi = lane & 8; const float send = hi ? a2[0] : a2[1]; const float keep = hi ? a2[1] : a2[0]; a1 = keep + __shfl_xor(send, 8); }
            a1 += __shfl_xor(a1, 4); a1 += __shfl_xor(a1, 2); a1 += __shfl_xor(a1, 1);
            if ((lane & 7) == 0) O[o + vs * 8 + (lane >> 3)] = a1;
        }
    }
}
__device__ __forceinline__ void phase_hnorm(const Params& p, int g) {
    const int tid = opaque_tid(), lane = tid & 63, nw = blockDim.x >> 6;
    for (int item = blockIdx.x * nw + (tid >> 6); item < MG * NH; item += gridDim.x * nw) {
        const int row = item >> 3, h = item & 7;
        const size_t o = (size_t)row * DM + h * 128 + 2 * lane;
        const f32x2v a = *(const f32x2v*)((const float*)(p.ws + WS_OF) + o), b = *(const f32x2v*)((const float*)(p.ws + WS_STATE) + o);
        const float o0 = a.x + b.x, o1 = a.y + b.y; const float ss = wave_sum(o0 * o0 + o1 * o1);
        const float r = 1.0f / sqrtf(ss * (1.0f / 128.0f) + EPS);
        const unsigned zw = *(const unsigned*)((const bf16_t*)(p.ws + WS_P) + PJ_ZB * PSTRIDE + o);
        const float y0 = o0 * r * p.gn_g[h * 128 + 2 * lane] * bflo(zw), y1 = o1 * r * p.gn_g[h * 128 + 2 * lane + 1] * bfhi(zw);
        *(unsigned*)((bf16_t*)(p.ws + WS_MIX) + (size_t)row * DMIX + DM + h * 128 + 2 * lane) = pk2(y0, y1);
    }
}

typedef float f32x16 __attribute__((ext_vector_type(16)));
typedef short s16x4 __attribute__((ext_vector_type(4)));
typedef __bf16 bf16x2c __attribute__((ext_vector_type(2)));
#define MFMA32(a, b, c) __builtin_amdgcn_mfma_f32_32x32x16_bf16((a), (b), (c), 0, 0, 0)
__device__ __forceinline__ unsigned pk2c(float lo, float hi) { return __builtin_bit_cast(unsigned, __builtin_convertvector((f32x2v){lo, hi}, bf16x2c)); }
__device__ __forceinline__ int crow(int reg, int h) { return (reg & 3) + 8 * (reg >> 2) + 4 * h; }
constexpr int SC = 256, NSC = MG / SC;
constexpr int HALF_LDS = 73728;
constexpr int QT_OFF = 0, QT_STR = 272;
constexpr int KT_OFF = 64 * QT_STR, KT_STR = 144;
constexpr int VT_OFF = KT_OFF + 128 * KT_STR;
constexpr int AT_OFF = VT_OFF + 128 * KT_STR, AT_STR = 144;
constexpr int SEG_OFF = AT_OFF + 64 * AT_STR;
constexpr int EEND_OFF = SEG_OFF + 2048;
constexpr int NRM_OFF = EEND_OFF + 512;
static_assert(NRM_OFF + 1024 <= HALF_LDS && 2 * HALF_LDS <= LDS_BYTES, "scan LDS map");
constexpr size_t STATE_SZ = 128 * 128;

template <int MODE>
__device__ __forceinline__ void scan_sweep(const Params& p, LAS unsigned char* hl, int sc, int h, int dir, int hw, int lane, bool valid) {
    const int r = lane & 31, h_ = lane >> 5;
    const bf16_t* P = (const bf16_t*)(p.ws + WS_P);
    float* state = (float*)(p.ws + WS_STATE) + ((size_t)(sc * NH + h) * 2 + dir) * STATE_SZ;
    float* OF = (float*)(p.ws + WS_OF);
    f32x16 S[4];
#pragma unroll
    for (int m = 0; m < 4; ++m)
#pragma unroll
        for (int i = 0; i < 16; ++i) S[m][i] = (MODE != 0 && valid) ? state[(32 * m + crow(i, h_)) * 128 + 32 * hw + r] : 0.f;
    float dprod0 = 1.f, dprod1 = 1.f;
    const int sc0 = sc * SC;
    const int trb = KT_OFF + (8 * h_ + ((lane & 15) >> 2)) * KT_STR + (16 * ((lane >> 4) & 1) + 4 * (lane & 3)) * 2;
#pragma unroll 1
    for (int j = 0; j < 4; ++j) {
        const int base = sc0 + 64 * (dir ? 3 - j : j);
        {
            unsigned kw[16], vw[16], qw[16];
            const size_t colo = (size_t)h * 128 + 2 * lane;
#pragma unroll
            for (int i = 0; i < 16; ++i) { const int tau = 16 * hw + i; const size_t o = (size_t)(dir ? base + 63 - tau : base + tau) * DM + colo;
                kw[i] = valid ? *(const unsigned*)(P + (PJ_KF + dir) * PSTRIDE + o) : 0u; vw[i] = valid ? *(const unsigned*)(P + PJ_I * PSTRIDE + o) : 0u;
                if (MODE != 0) qw[i] = valid ? *(const unsigned*)(P + PJ_Q * PSTRIDE + o) : 0u; }
            float e0 = 1.f, e1 = 1.f;
#pragma unroll
            for (int i = 0; i < 16; ++i) { e0 *= 1.0f - bflo(kw[i]); e1 *= 1.0f - bfhi(kw[i]); }
            *(LAS f32x2v*)(hl + SEG_OFF + (hw * 128 + 2 * lane) * 4) = (f32x2v){e0, e1};
            __syncthreads();
            float off0 = 1.f, off1 = 1.f, tot0 = 1.f, tot1 = 1.f;
#pragma unroll
            for (int w = 0; w < 4; ++w) { const f32x2v sg = *(const LAS f32x2v*)(hl + SEG_OFF + (w * 128 + 2 * lane) * 4); if (w < hw) { off0 *= sg.x; off1 *= sg.y; } tot0 *= sg.x; tot1 *= sg.y; }
            if (hw == 0) *(LAS f32x2v*)(hl + EEND_OFF + 2 * lane * 4) = (f32x2v){tot0, tot1};
            dprod0 *= tot0; dprod1 *= tot1;
            e0 = off0; e1 = off1;
            unsigned kt0[8], kt1[8], vt0[8], vt1[8];
#pragma unroll
            for (int i2 = 0; i2 < 8; ++i2) {
                float ka[2], kb[2];
#pragma unroll
                for (int u = 0; u < 2; ++u) { const int i = 2 * i2 + u; const float k0 = bflo(kw[i]), k1 = bfhi(kw[i]);
                    e0 *= 1.0f - k0; e1 *= 1.0f - k1;
                    ka[u] = k0 * fast_rcp(e0); kb[u] = k1 * fast_rcp(e1);
                    if (MODE != 0) *(LAS unsigned*)(hl + QT_OFF + (16 * hw + i) * QT_STR + 4 * lane) = pk2c(bflo(qw[i]) * e0, bfhi(qw[i]) * e1); }
                kt0[i2] = pk2c(ka[0], ka[1]); kt1[i2] = pk2c(kb[0], kb[1]);
                vt0[i2] = (vw[2 * i2] & 0xffffu) | (vw[2 * i2 + 1] << 16); vt1[i2] = (vw[2 * i2] >> 16) | (vw[2 * i2 + 1] & 0xffff0000u);
            }
            LAS unsigned char* kp = hl + KT_OFF + (2 * lane) * KT_STR + 32 * hw; LAS unsigned char* vp = hl + VT_OFF + (2 * lane) * KT_STR + 32 * hw;
            *(LAS u32x4*)(kp) = (u32x4){kt0[0], kt0[1], kt0[2], kt0[3]}; *(LAS u32x4*)(kp + 16) = (u32x4){kt0[4], kt0[5], kt0[6], kt0[7]};
            *(LAS u32x4*)(kp + KT_STR) = (u32x4){kt1[0], kt1[1], kt1[2], kt1[3]}; *(LAS u32x4*)(kp + KT_STR + 16) = (u32x4){kt1[4], kt1[5], kt1[6], kt1[7]};
            *(LAS u32x4*)(vp) = (u32x4){vt0[0], vt0[1], vt0[2], vt0[3]}; *(LAS u32x4*)(vp + 16) = (u32x4){vt0[4], vt0[5], vt0[6], vt0[7]};
            *(LAS u32x4*)(vp + KT_STR) = (u32x4){vt1[0], vt1[1], vt1[2], vt1[3]}; *(LAS u32x4*)(vp + KT_STR + 16) = (u32x4){vt1[4], vt1[5], vt1[6], vt1[7]};
        }
        __syncthreads();
        f32x16 O[2];
        if (MODE != 0) {
            if (hw < 3) {
                const int si = hw >> 1, tj = (hw + 1) >> 1;
                f32x16 a;
#pragma unroll
                for (int i = 0; i < 16; ++i) a[i] = 0.f;
#pragma unroll
                for (int ks = 0; ks < 8; ++ks) {
                    LAS unsigned char* tp = hl + trb + ks * 16 * KT_STR + si * 64;
                    const s16x4 lo = __builtin_amdgcn_ds_read_tr16_b64_v4i16((LAS s16x4*)tp), hi = __builtin_amdgcn_ds_read_tr16_b64_v4i16((LAS s16x4*)(tp + 4 * KT_STR));
                    const bf16x8 af = __builtin_shufflevector(lo, hi, 0, 1, 2, 3, 4, 5, 6, 7);
                    const bf16x8 bq = *(const LAS bf16x8*)(hl + QT_OFF + (32 * tj + r) * QT_STR + ks * 32 + 16 * h_);
                    a = MFMA32(af, bq, a);
                }
#pragma unroll
                for (int g = 0; g < 4; ++g) { float x[4];
#pragma unroll
                    for (int e = 0; e < 4; ++e) { x[e] = a[4 * g + e]; if (si == tj && 8 * g + 4 * h_ + e > r) x[e] = 0.f; }
                    *(LAS u32x2*)(hl + AT_OFF + (32 * tj + r) * AT_STR + (32 * si + 8 * g + 4 * h_) * 2) = (u32x2){pk2c(x[0], x[1]), pk2c(x[2], x[3])}; }
            }
#pragma unroll
            for (int tj = 0; tj < 2; ++tj) { const int tau = 32 * tj + r; const size_t o = (size_t)(base + 63 - tau) * DM + h * 128 + 32 * hw + 4 * h_;
#pragma unroll
                for (int g = 0; g < 4; ++g) { f32x4 v = {0.f, 0.f, 0.f, 0.f}; if (MODE == 2 && valid) v = *(const f32x4*)(OF + o + 8 * g);
                    O[tj][4 * g] = v[0]; O[tj][4 * g + 1] = v[1]; O[tj][4 * g + 2] = v[2]; O[tj][4 * g + 3] = v[3]; } }
            __syncthreads();
        }
        bf16x8 vf[4];
#pragma unroll
        for (int ks = 0; ks < 4; ++ks) vf[ks] = *(const LAS bf16x8*)(hl + VT_OFF + (32 * hw + r) * KT_STR + ks * 32 + 16 * h_);
        if (MODE != 0) {
#pragma unroll
            for (int tj = 0; tj < 2; ++tj)
#pragma unroll
                for (int ks = 0; ks < 4; ++ks) if (tj == 1 || ks < 2) {
                    const bf16x8 ba = *(const LAS bf16x8*)(hl + AT_OFF + (32 * tj + r) * AT_STR + ks * 32 + 16 * h_);
                    O[tj] = MFMA32(vf[ks], ba, O[tj]); }
#pragma unroll
            for (int m = 0; m < 4; ++m)
#pragma unroll
                for (int s2 = 0; s2 < 2; ++s2) {
                    const u32x4 pa = {pk2c(S[m][8 * s2], S[m][8 * s2 + 1]), pk2c(S[m][8 * s2 + 2], S[m][8 * s2 + 3]), pk2c(S[m][8 * s2 + 4], S[m][8 * s2 + 5]), pk2c(S[m][8 * s2 + 6], S[m][8 * s2 + 7])};
                    const bf16x8 af = __builtin_bit_cast(bf16x8, pa);
#pragma unroll
                    for (int tj = 0; tj < 2; ++tj) { const LAS unsigned char* qp = hl + QT_OFF + (32 * tj + r) * QT_STR + (32 * m + 16 * s2 + 4 * h_) * 2;
                        const u32x2 b0 = *(const LAS u32x2*)qp, b1 = *(const LAS u32x2*)(qp + 16);
                        const bf16x8 bq = __builtin_bit_cast(bf16x8, ((u32x4){b0.x, b0.y, b1.x, b1.y}));
                        O[tj] = MFMA32(af, bq, O[tj]); }
                }
        }
#pragma unroll
        for (int m = 0; m < 4; ++m) {
#pragma unroll
            for (int ks = 0; ks < 4; ++ks) { const bf16x8 af = *(const LAS bf16x8*)(hl + KT_OFF + (32 * m + r) * KT_STR + ks * 32 + 16 * h_); S[m] = MFMA32(af, vf[ks], S[m]); }
#pragma unroll
            for (int g = 0; g < 4; ++g) { const f32x4 ee = *(const LAS f32x4*)(hl + EEND_OFF + (32 * m + 8 * g + 4 * h_) * 4);
                S[m][4 * g] *= ee[0]; S[m][4 * g + 1] *= ee[1]; S[m][4 * g + 2] *= ee[2]; S[m][4 * g + 3] *= ee[3]; }
        }
        if (MODE == 1) {
#pragma unroll
            for (int tj = 0; tj < 2; ++tj) { const size_t o = (size_t)(base + 32 * tj + r) * DM + h * 128 + 32 * hw + 4 * h_;
#pragma unroll
                for (int g = 0; g < 4; ++g) if (valid) *(f32x4*)(OF + o + 8 * g) = (f32x4){O[tj][4 * g], O[tj][4 * g + 1], O[tj][4 * g + 2], O[tj][4 * g + 3]}; }
        }
        if (MODE == 2) {
#pragma unroll
            for (int tj = 0; tj < 2; ++tj) { float ss = 0.f;
#pragma unroll
                for (int i = 0; i < 16; ++i) ss += O[tj][i] * O[tj][i];
                ss += __shfl_xor(ss, 32);
                if (h_ == 0) *(LAS float*)(hl + NRM_OFF + (hw * 64 + 32 * tj + r) * 4) = ss; }
            __syncthreads();
#pragma unroll
            for (int tj = 0; tj < 2; ++tj) { const int tau = 32 * tj + r; float tot = 0.f;
#pragma unroll
                for (int w = 0; w < 4; ++w) tot += *(const LAS float*)(hl + NRM_OFF + (w * 64 + tau) * 4);
                const float rinv = 1.0f / sqrtf(tot * (1.0f / 128.0f) + EPS);
                const int tok = base + 63 - tau, v0 = h * 128 + 32 * hw + 4 * h_;
#pragma unroll
                for (int g = 0; g < 4; ++g) if (valid) { const f32x4 gn = *(const f32x4*)(p.gn_g + v0 + 8 * g); const u32x2 zb = *(const u32x2*)(P + PJ_ZB * PSTRIDE + (size_t)tok * DM + v0 + 8 * g);
                    const float y0 = O[tj][4 * g] * rinv * gn[0] * bflo(zb.x), y1 = O[tj][4 * g + 1] * rinv * gn[1] * bfhi(zb.x), y2 = O[tj][4 * g + 2] * rinv * gn[2] * bflo(zb.y), y3 = O[tj][4 * g + 3] * rinv * gn[3] * bfhi(zb.y);
                    *(u32x2*)((bf16_t*)(p.ws + WS_MIX) + (size_t)tok * DMIX + DM + v0 + 8 * g) = (u32x2){pk2c(y0, y1), pk2c(y2, y3)}; } }
        } else {
            __syncthreads();
        }
    }
    if (MODE == 0 && valid) {
#pragma unroll
        for (int m = 0; m < 4; ++m)
#pragma unroll
            for (int i = 0; i < 16; ++i) state[(32 * m + crow(i, h_)) * 128 + 32 * hw + r] = S[m][i];
        if (hw == 0) *(f32x2v*)((float*)(p.ws + WS_DEC) + ((size_t)(sc * NH + h) * 2 + dir) * 128 + 2 * lane) = (f32x2v){dprod0, dprod1};
    }
}
constexpr int VN_OFF = 0, VN_STR = 272, GST_OFF = 128 * VN_STR;
static_assert(GST_OFF + 1024 <= HALF_LDS, "gmlp LDS map");
__device__ __forceinline__ void gmlp_item(const Params& p, LAS unsigned char* hl, int item, int hw, int lane, bool valid) {
    const int r = lane & 31, h_ = lane >> 5, chunk = item >> 3, h = item & 7, r0 = chunk * 128;
    const bf16_t* P = (const bf16_t*)(p.ws + WS_P);
    { const int s = hw * 64 + lane;
      if (s < 128) { float sm = 0.f, sq = 0.f;
          if (valid) { const f32x4* vs = (const f32x4*)((const float*)(p.ws + WS_VSTAT) + (size_t)(r0 + s) * 32);
#pragma unroll
              for (int i = 0; i < 8; ++i) { const f32x4 x = vs[i]; sm += x[0] + x[2]; sq += x[1] + x[3]; } }
          const float mean = sm * (1.0f / DM), var = sq * (1.0f / DM) - mean * mean;
          *(LAS float*)(hl + GST_OFF + s * 4) = mean; *(LAS float*)(hl + GST_OFF + 512 + s * 4) = 1.0f / sqrtf(var + EPS); } }
    __syncthreads();
    { const int c0 = h * 128 + 2 * lane; const float g0 = p.ln_v_g[c0], g1 = p.ln_v_g[c0 + 1], b0 = p.ln_v_b[c0], b1 = p.ln_v_b[c0 + 1];
      unsigned n0[16], n1[16];
#pragma unroll
      for (int i2 = 0; i2 < 16; ++i2) { float a[2], b[2];
#pragma unroll
          for (int u = 0; u < 2; ++u) { const int s = 32 * hw + 2 * i2 + u; const unsigned vw = valid ? *(const unsigned*)(P + PJ_V * PSTRIDE + (size_t)(r0 + s) * DM + c0) : 0u;
              const float mu = *(const LAS float*)(hl + GST_OFF + s * 4), rs = *(const LAS float*)(hl + GST_OFF + 512 + s * 4);
              a[u] = (bflo(vw) - mu) * rs * g0 + b0; b[u] = (bfhi(vw) - mu) * rs * g1 + b1; }
          n0[i2] = pk2c(a[0], a[1]); n1[i2] = pk2c(b[0], b[1]); }
      LAS unsigned char* np = hl + VN_OFF + (2 * lane) * VN_STR + 64 * hw;
#pragma unroll
      for (int k = 0; k < 4; ++k) { *(LAS u32x4*)(np + 16 * k) = (u32x4){n0[4 * k], n0[4 * k + 1], n0[4 * k + 2], n0[4 * k + 3]}; *(LAS u32x4*)(np + VN_STR + 16 * k) = (u32x4){n1[4 * k], n1[4 * k + 1], n1[4 * k + 2], n1[4 * k + 3]}; } }
    __syncthreads();
    f32x16 acc[4];
#pragma unroll
    for (int m = 0; m < 4; ++m)
#pragma unroll
        for (int i = 0; i < 16; ++i) acc[m][i] = 0.f;
    const bf16_t* wrow = (const bf16_t*)(p.ws + WS_WSB) + ((size_t)h * 128 + 32 * hw + r) * 128 + 8 * h_;
#pragma unroll
    for (int ks = 0; ks < 8; ++ks) { const bf16x8 wf = *(const bf16x8*)(wrow + 16 * ks);
#pragma unroll
        for (int m = 0; m < 4; ++m) { const bf16x8 af = *(const LAS bf16x8*)(hl + VN_OFF + (32 * m + r) * VN_STR + ks * 32 + 16 * h_); acc[m] = MFMA32(af, wf, acc[m]); } }
    const int t = 32 * hw + r, tok = r0 + t; const float bs = p.b_s[h * 128 + t];
    if (valid) {
#pragma unroll
        for (int m = 0; m < 4; ++m)
#pragma unroll
            for (int g = 0; g < 4; ++g) { const size_t o = (size_t)tok * DM + h * 128 + 32 * m + 8 * g + 4 * h_;
                const u32x2 uw = *(const u32x2*)(P + PJ_U * PSTRIDE + o), zw = *(const u32x2*)(P + PJ_ZA * PSTRIDE + o);
                const float y0 = bflo(uw.x) * (acc[m][4 * g] + bs) * bflo(zw.x), y1 = bfhi(uw.x) * (acc[m][4 * g + 1] + bs) * bfhi(zw.x), y2 = bflo(uw.y) * (acc[m][4 * g + 2] + bs) * bflo(zw.y), y3 = bfhi(uw.y) * (acc[m][4 * g + 3] + bs) * bfhi(zw.y);
                *(u32x2*)((bf16_t*)(p.ws + WS_MIX) + (size_t)tok * DMIX + h * 128 + 32 * m + 8 * g + 4 * h_) = (u32x2){pk2c(y0, y1), pk2c(y2, y3)}; }
    }
    __syncthreads();
}
__device__ __forceinline__ void phase_gmlp_scan1(const Params& p, int g, LAS unsigned char* lds) {
    const int tid = opaque_tid(), lane = tid & 63, wave = __builtin_amdgcn_readfirstlane(tid >> 6), half = wave >> 2, hw = wave & 3;
    LAS unsigned char* hl = lds + half * HALF_LDS;
    const int hb = blockIdx.x * 2 + half, NHB = gridDim.x * 2;
    constexpr int NG = (MG / 128) * NH, NS1 = NSC * NH * 2;
    for (int i = 0; i < (NG + NHB - 1) / NHB; ++i) { const int item = hb + i * NHB; gmlp_item(p, hl, item < NG ? item : 0, hw, lane, item < NG); }
    for (int i = 0; i < (NS1 + NHB - 1) / NHB; ++i) { const int item = hb + i * NHB; const bool valid = item < NS1; const int it = valid ? item : 0;
        scan_sweep<0>(p, hl, it >> 4, (it >> 1) & 7, it & 1, hw, lane, valid); }
}
__device__ __forceinline__ void phase_scan2(const Params& p, int g) {
    const int tid = opaque_tid();
    const int nseq = g < 2 ? 2 : 1, nsc = NSC / nseq;
    float* state = (float*)(p.ws + WS_STATE); const float* dec = (const float*)(p.ws + WS_DEC);
    for (int idx = blockIdx.x * blockDim.x + tid; idx < nseq * NH * 2 * 4096; idx += gridDim.x * blockDim.x) {
        const int e4 = idx & 4095, dir = (idx >> 12) & 1, h = (idx >> 13) & 7, seq = idx >> 16, c = e4 >> 5;
        f32x4 carry = {0.f, 0.f, 0.f, 0.f};
#pragma unroll 4
        for (int n = 0; n < nsc; ++n) { const int scn = seq * nsc + (dir ? nsc - 1 - n : n); const size_t sb = (size_t)(scn * NH + h) * 2 + dir;
            f32x4* sp = (f32x4*)(state + sb * STATE_SZ) + e4; const f32x4 tmp = *sp; *sp = carry; const float d = dec[sb * 128 + c]; carry = carry * d + tmp; }
    }
}
__device__ __forceinline__ void phase_scan3(const Params& p, int g, LAS unsigned char* lds) {
    const int tid = opaque_tid(), lane = tid & 63, wave = __builtin_amdgcn_readfirstlane(tid >> 6), half = wave >> 2, hw = wave & 3;
    LAS unsigned char* hl = lds + half * HALF_LDS;
    const int hb = blockIdx.x * 2 + half, NHB = gridDim.x * 2;
    constexpr int NS3 = NSC * NH;
    for (int i = 0; i < (NS3 + NHB - 1) / NHB; ++i) { const int item = hb + i * NHB; const bool valid = item < NS3; const int it = valid ? item : 0;
        scan_sweep<1>(p, hl, it >> 3, it & 7, 0, hw, lane, valid);
        asm volatile("s_waitcnt vmcnt(0)" ::: "memory"); __syncthreads();
        __builtin_amdgcn_fence(__ATOMIC_ACQUIRE, "agent"); asm volatile("s_waitcnt vmcnt(0)" ::: "memory"); __syncthreads();
        scan_sweep<2>(p, hl, it >> 3, it & 7, 1, hw, lane, valid);
    }
}

typedef __attribute__((address_space(1))) unsigned gu32;
#define XB_TMO      128
#define XB_XCNT(j)  (256  + 64 * (j))
#define XB_XSUB(j)  (1280 + 64 * (j))
#define XB_XGEN(j)  (2304 + 64 * (j))
#define XB_TOP      3328
#define XB_TOPGEN   3392
#define XCD_BAR_WORDS 3456
#define XB_SPIN_CAP (1u << 18)

__device__ __forceinline__ unsigned xb_ld(unsigned* p)              { return __hip_atomic_load(p, __ATOMIC_RELAXED, __HIP_MEMORY_SCOPE_AGENT); }
__device__ __forceinline__ unsigned xb_add(unsigned* p, unsigned v) { return __hip_atomic_fetch_add(p, v, __ATOMIC_RELAXED, __HIP_MEMORY_SCOPE_AGENT); }
__device__ __forceinline__ unsigned xb_xcc_id() { return (unsigned)__builtin_amdgcn_s_getreg((3 << 11) | 20) & 0xFu; }
#define XB_SPIN(cond, bar) do { unsigned _sp = 0; while (cond) { __builtin_amdgcn_s_sleep(1); \
    if ((++_sp & 255u) == 0u) { if (xb_ld(&(bar)[XB_TMO])) break; if (_sp > XB_SPIN_CAP) { atomicAdd(&(bar)[XB_TMO], 1u); break; } } } } while (0)

struct XcdBarrier {
    unsigned* bar; unsigned x;
    volatile LAS unsigned* st;
};

__device__ __forceinline__ XcdBarrier xcd_barrier_post(unsigned* bar, volatile LAS unsigned* st) {
    XcdBarrier b; b.bar = bar; b.x = xb_xcc_id(); b.st = st;
    if (threadIdx.x == 0) (void)xb_add(&bar[XB_XCNT(b.x)], 1u);
    return b;
}
__device__ __forceinline__ void xcd_barrier_complete(unsigned* bar, unsigned x, unsigned& nloc, unsigned& nx) {
    const unsigned G = gridDim.x * gridDim.y * gridDim.z;
    unsigned sum, cnt, mine, sp = 0u;
    for (;;) {
        sum = 0u; cnt = 0u; mine = 0u;
#pragma unroll
        for (unsigned j = 0; j < 16; ++j) { const unsigned c = xb_ld(&bar[XB_XCNT(j)]); sum += c; cnt += (c > 0u) ? 1u : 0u; mine = (j == x) ? c : mine; }
        if (sum == G) break;
        __builtin_amdgcn_s_sleep(1);
        if ((++sp & 255u) == 0u) { if (xb_ld(&bar[XB_TMO])) break; if (sp > XB_SPIN_CAP) { atomicAdd(&bar[XB_TMO], 1u); break; } }
    }
    nloc = mine > 0u ? mine : 1u; nx = cnt > 0u ? cnt : 1u;
}

__device__ __forceinline__ void xcd_barrier(const XcdBarrier& b) {
    asm volatile("s_waitcnt vmcnt(0)" ::: "memory");
    __syncthreads();
    if (threadIdx.x == 0) {
        unsigned* bar = b.bar;
        __builtin_amdgcn_s_waitcnt(0);
        unsigned nloc = b.st[0], nx = b.st[1];
        if (nloc == 0u) { xcd_barrier_complete(bar, b.x, nloc, nx); b.st[0] = nloc; b.st[1] = nx; }
        const unsigned old = xb_add(&bar[XB_XSUB(b.x)], 1u);
        const unsigned gen = old / nloc;
        if (old + 1u == (gen + 1u) * nloc) {
            __builtin_amdgcn_fence(__ATOMIC_RELEASE, "agent");
            asm volatile("s_waitcnt vmcnt(0)" ::: "memory");
            const unsigned og = xb_add(&bar[XB_TOP], 1u);
            const unsigned tg = og / nx;
            if (og + 1u == (tg + 1u) * nx) xb_add(&bar[XB_TOPGEN], 1u);
            else XB_SPIN(xb_ld(&bar[XB_TOPGEN]) == tg, bar);
            __builtin_amdgcn_fence(__ATOMIC_ACQUIRE, "agent");
            xb_add(&bar[XB_XGEN(b.x)], 1u);
            asm volatile("s_waitcnt vmcnt(0)" ::: "memory");
        } else {
            XB_SPIN(xb_ld(&bar[XB_XGEN(b.x)]) == gen, bar);
            __builtin_amdgcn_fence(__ATOMIC_ACQUIRE, "agent");
            asm volatile("s_waitcnt vmcnt(0)" ::: "memory");
        }
    }
    __syncthreads();
}

constexpr int CW_BAR = 4096;
constexpr int MISC_OFF = LDS_BYTES - 128;
constexpr size_t CTL_ZERO_BYTES = 65536;
__global__ void __launch_bounds__(512, 2) k_mega(Params p) {
    LAS unsigned char* lds = (LAS unsigned char*)lds_raw;
    volatile LAS unsigned* misc = (volatile LAS unsigned*)(lds + MISC_OFF);
    if (threadIdx.x < 32) misc[threadIdx.x] = 0u;
    __syncthreads();
    const XcdBarrier bar = xcd_barrier_post((unsigned*)(p.ws + WS_CTL) + CW_BAR, misc);
    phase_prologue(p, lds);
    xcd_barrier(bar);
    for (int g = 0; g < NGROUPS; ++g) {
        phase_gemm_in(p, g, lds);
        xcd_barrier(bar);
        phase_gmlp_scan1(p, g, lds);
        xcd_barrier(bar);
        phase_scan2(p, g);
        xcd_barrier(bar);
        phase_scan3(p, g, lds);
        xcd_barrier(bar);
        phase_gemm_out(p, g, lds);
        xcd_barrier(bar);
        phase_final(p, g);
    }
}

extern "C" void kernel_launch(void* const* d_in, const int* in_sizes, int n_in, void* d_out, int out_size, void* d_ws, size_t ws_size, hipStream_t stream) {
    static int grid = 0;
    if (grid == 0) {
        if (n_in != 12 || out_size != T_ALL * DM || ws_size < WS_END) { fprintf(stderr, "kernel_launch: unexpected shapes (n_in %d out %d ws %zu)\n", n_in, out_size, ws_size); grid = -1; return; }
        int dev = 0, cus = 0, per_cu = 0;
        if (hipGetDevice(&dev) != hipSuccess || hipDeviceGetAttribute(&cus, hipDeviceAttributeMultiprocessorCount, dev) != hipSuccess) { grid = -1; return; }
        if (hipFuncSetAttribute((const void*)k_mega, hipFuncAttributeMaxDynamicSharedMemorySize, LDS_BYTES) != hipSuccess) { fprintf(stderr, "kernel_launch: hipFuncSetAttribute failed\n"); grid = -1; return; }
        if (hipOccupancyMaxActiveBlocksPerMultiprocessor(&per_cu, (const void*)k_mega, 512, LDS_BYTES) != hipSuccess || per_cu < 1) { fprintf(stderr, "kernel_launch: occupancy query failed (%d)\n", per_cu); grid = -1; return; }
        grid = cus;
    }
    if (grid < 0) return;
    Params p{};
    p.x_prompt = (const float*)d_in[0]; p.x_sample = (const float*)d_in[1]; p.norm_g = (const float*)d_in[2]; p.w_in = (const float*)d_in[3];
    p.ln_v_g = (const float*)d_in[4]; p.ln_v_b = (const float*)d_in[5]; p.w_s = (const float*)d_in[6]; p.b_s = (const float*)d_in[7];
    p.lb_params = (const float*)d_in[8]; p.gn_g = (const float*)d_in[9]; p.w_out = (const float*)d_in[10]; p.final_g = (const float*)d_in[11];
    p.out = (float*)d_out; p.ws = (unsigned char*)d_ws;
    if (hipMemsetAsync((unsigned char*)d_ws + WS_CTL, 0, CTL_ZERO_BYTES, stream) != hipSuccess) { fprintf(stderr, "kernel_launch: memset failed\n"); return; }
    hipLaunchKernelGGL(k_mega, dim3(grid), dim3(512), LDS_BYTES, stream, p);
    const hipError_t e = hipPeekAtLastError();
    if (e != hipSuccess) fprintf(stderr, "kernel_launch: launch failed: %s (grid %d)\n", hipGetErrorString(e), grid);
}
```
